# Optimizing an MI355X kernel written in HIP

```python
import jax, jax.numpy as jnp
from jax import lax
import numpy as np

D_MODEL = 2048
BATCH = 2
SEQ = 4096
DEPTH = 2

N_MIXERS = 2
N_GLA_LAYERS = (DEPTH + 1) // 2
N_FOX_LAYERS = DEPTH // 2

GLA_HEADS = 4
GLA_KEY_DIM = D_MODEL // 2
GLA_VAL_DIM = D_MODEL
GLA_HEAD_K = GLA_KEY_DIM // GLA_HEADS
GLA_HEAD_V = GLA_VAL_DIM // GLA_HEADS
GLA_GATE_RANK = 16
GLA_GATE_TEMP = 16.0
GLA_CHUNK = 64
GLA_IN = 2 * GLA_KEY_DIM + 2 * GLA_VAL_DIM + GLA_GATE_RANK

FOX_HEAD_DIM = 128
FOX_HEADS = D_MODEL // FOX_HEAD_DIM
FOX_BLOCK = 128
FOX_IN = 4 * D_MODEL + FOX_HEADS

D_FF = ((8 * D_MODEL + 2) // 3 + 255) // 256 * 256

RMS_EPS = 1e-6

kernel_name = "hybrid_gla_fox_interleaved"


def rms_norm(x, g):
    xf = x.astype(jnp.float32)
    y = xf * lax.rsqrt(jnp.mean(xf * xf, axis=-1, keepdims=True) + RMS_EPS)
    return (y * g.astype(jnp.float32)).astype(x.dtype)


def gla_mixer(h, w_in, w_g2, b_g2, o_gain, w_o):
    B, S, _ = h.shape
    H, HK, HV, C = GLA_HEADS, GLA_HEAD_K, GLA_HEAD_V, GLA_CHUNK
    proj = h @ w_in
    q, k, v, r, g_lr = jnp.split(
        proj, [GLA_KEY_DIM, 2 * GLA_KEY_DIM, 2 * GLA_KEY_DIM + GLA_VAL_DIM,
               2 * GLA_KEY_DIM + 2 * GLA_VAL_DIM], axis=-1)
    log_a = jax.nn.log_sigmoid((g_lr @ w_g2 + b_g2).astype(jnp.float32)) / GLA_GATE_TEMP

    def heads(t, dh):
        return t.reshape(B, S, H, dh).transpose(0, 2, 1, 3).astype(jnp.float32)

    q = heads(q, HK) * (HK ** -0.5)
    k = heads(k, HK)
    v = heads(v, HV)
    la = heads(log_a, HK)
    nc = S // C

    def chunks(t):
        return t.reshape(B, H, nc, C, t.shape[-1]).transpose(2, 0, 1, 3, 4)

    qc, kc, vc = chunks(q), chunks(k), chunks(v)
    bc = jnp.cumsum(chunks(la), axis=-2)
    causal = jnp.tril(jnp.ones((C, C), dtype=bool))

    def step(state, inp):
        q_i, k_i, v_i, b_i = inp
        diff = b_i[:, :, :, None, :] - b_i[:, :, None, :, :]
        decay = jnp.exp(jnp.where(causal[:, :, None], diff, -jnp.inf))
        attn = jnp.einsum('bhtk,bhsk,bhtsk->bhts', q_i, k_i, decay)
        o = attn @ v_i + jnp.einsum('bhtk,bhkv->bhtv', q_i * jnp.exp(b_i), state)
        b_last = b_i[:, :, -1:, :]
        state = (jnp.exp(b_last[:, :, 0, :])[..., None] * state
                 + jnp.einsum('bhsk,bhsv->bhkv', k_i * jnp.exp(b_last - b_i), v_i))
        return state, o

    state0 = jnp.zeros((B, H, HK, HV), jnp.float32)
    _, o = lax.scan(step, state0, (qc, kc, vc, bc))
    o = o.transpose(1, 0, 3, 2, 4).reshape(B, S, H, HV)
    o = rms_norm(o, o_gain).reshape(B, S, GLA_VAL_DIM).astype(h.dtype)
    return (o * jax.nn.silu(r)) @ w_o


def fox_mixer(h, w_in, b_f, q_gain, k_gain, w_o):
    B, S, _ = h.shape
    H, HD, BLK = FOX_HEADS, FOX_HEAD_DIM, FOX_BLOCK
    proj = h @ w_in
    q, k, v, f_lr, og = jnp.split(
        proj, [D_MODEL, 2 * D_MODEL, 3 * D_MODEL, 3 * D_MODEL + H], axis=-1)
    q = rms_norm(q.reshape(B, S, H, HD), q_gain).transpose(0, 2, 1, 3)
    k = rms_norm(k.reshape(B, S, H, HD), k_gain).transpose(0, 2, 1, 3)
    v = v.reshape(B, S, H, HD).transpose(0, 2, 1, 3)
    log_f = jax.nn.log_sigmoid((f_lr + b_f).astype(jnp.float32))
    c = jnp.cumsum(log_f.transpose(0, 2, 1), axis=-1)
    scale = HD ** -0.5
    nb = S // BLK
    q_blocks = q.reshape(B, H, nb, BLK, HD).transpose(2, 0, 1, 3, 4)
    cq_blocks = c.reshape(B, H, nb, BLK).transpose(2, 0, 1, 3)
    key_pos = jnp.arange(S)

    def block(args):
        qb, cqb, i = args
        q_pos = i * BLK + jnp.arange(BLK)
        logits = jnp.einsum('bhqd,bhkd->bhqk', qb, k).astype(jnp.float32) * scale
        logits = logits + (cqb[..., None] - c[:, :, None, :])
        logits = jnp.where(key_pos[None, :] <= q_pos[:, None], logits, -jnp.inf)
        p = jax.nn.softmax(logits, axis=-1)
        return jnp.einsum('bhqk,bhkd->bhqd', p.astype(v.dtype), v)

    o = lax.map(block, (q_blocks, cq_blocks, jnp.arange(nb)))
    o = o.transpose(1, 0, 3, 2, 4).reshape(B, S, D_MODEL)
    return (o * jax.nn.sigmoid(og)) @ w_o


def swiglu(h, w_gate, w_up, w_down):
    return (jax.nn.silu(h @ w_gate) * (h @ w_up)) @ w_down


def setup_inputs(seed: int = 0) -> dict:
    key = jax.random.key(seed)
    ks = jax.random.split(key, 17)
    f32 = jnp.float32

    def nrm(k, shape, scale):
        return jax.random.normal(k, shape, f32) * scale

    D = D_MODEL
    return {
        "x": nrm(ks[0], (BATCH, SEQ, D), 1.0),
        "norm_mix": 1.0 + nrm(ks[1], (DEPTH, D), 0.02),
        "norm_ffn": 1.0 + nrm(ks[2], (DEPTH, D), 0.02),
        "gla_w_in": nrm(ks[3], (N_GLA_LAYERS, D, GLA_IN), D ** -0.5),
        "gla_w_g2": nrm(ks[4], (N_GLA_LAYERS, GLA_GATE_RANK, GLA_KEY_DIM), GLA_GATE_RANK ** -0.5),
        "gla_b_g2": nrm(ks[5], (N_GLA_LAYERS, GLA_KEY_DIM), 0.02),
        "gla_o_gain": 1.0 + nrm(ks[6], (N_GLA_LAYERS, GLA_HEAD_V), 0.02),
        "gla_w_o": nrm(ks[7], (N_GLA_LAYERS, GLA_VAL_DIM, D), GLA_VAL_DIM ** -0.5),
        "fox_w_in": nrm(ks[8], (N_FOX_LAYERS, D, FOX_IN), D ** -0.5),
        "fox_b_f": 1.0 + nrm(ks[9], (N_FOX_LAYERS, FOX_HEADS), 0.1),
        "fox_q_gain": 1.0 + nrm(ks[10], (N_FOX_LAYERS, FOX_HEAD_DIM), 0.02),
        "fox_k_gain": 1.0 + nrm(ks[11], (N_FOX_LAYERS, FOX_HEAD_DIM), 0.02),
        "fox_w_o": nrm(ks[12], (N_FOX_LAYERS, D, D), D ** -0.5),
        "ffn_w_gate": nrm(ks[13], (DEPTH, D, D_FF), D ** -0.5),
        "ffn_w_up": nrm(ks[14], (DEPTH, D, D_FF), D ** -0.5),
        "ffn_w_down": nrm(ks[15], (DEPTH, D_FF, D), D_FF ** -0.5),
    }


def reference(x, norm_mix, norm_ffn, gla_w_in, gla_w_g2, gla_b_g2, gla_o_gain, gla_w_o,
              fox_w_in, fox_b_f, fox_q_gain, fox_k_gain, fox_w_o,
              ffn_w_gate, ffn_w_up, ffn_w_down):
    for i in range(DEPTH):
        h = rms_norm(x, norm_mix[i])
        j = i // N_MIXERS
        if i % N_MIXERS == 0:
            mix = gla_mixer(h, gla_w_in[j], gla_w_g2[j], gla_b_g2[j], gla_o_gain[j], gla_w_o[j])
        else:
            mix = fox_mixer(h, fox_w_in[j], fox_b_f[j], fox_q_gain[j], fox_k_gain[j], fox_w_o[j])
        x = x + mix
        h = rms_norm(x, norm_ffn[i])
        x = x + swiglu(h, ffn_w_gate[i], ffn_w_up[i], ffn_w_down[i])
    return x
```

```cpp
#include <hip/hip_runtime.h>
#include <hip/hip_cooperative_groups.h>
#include <cstdio>
#include <cstdint>
namespace cg = cooperative_groups;
__device__ __forceinline__ int opaque_tid() { int t = threadIdx.x; asm volatile("" : "+v"(t)); return t; }
typedef float f32x2_t __attribute__((ext_vector_type(2))); typedef __bf16 bf16x2_t __attribute__((ext_vector_type(2)));
__device__ __forceinline__ unsigned cvtpk(float lo, float hi) { f32x2_t v = {lo, hi}; bf16x2_t b = __builtin_convertvector(v, bf16x2_t); return __builtin_bit_cast(unsigned, b); }
namespace pg8 {
#define PG8_LAS __attribute__((address_space(3)))
typedef unsigned short bf16_t;
typedef short bf16x8 __attribute__((ext_vector_type(8)));
typedef float f32x4 __attribute__((ext_vector_type(4)));
typedef unsigned u32x4 __attribute__((ext_vector_type(4)));
constexpr int BM = 256, BK = 64, HALF = 128, HTB = HALF * BK * 2  , STAGE_BYTES = 8 * HTB, NXCD = 8, WGM = 8;

__host__ __device__ __forceinline__ int lds_byte(int r, int c) { const int st = (r >> 4) * 2 + (c >> 5), rr = r & 15, cc = c & 31, ob = rr * 64 + cc * 2; return st * 1024 + (ob ^ (((ob >> 9) & 1) << 5)); }
__host__ __device__ __forceinline__ void stage_rc(int b, int& R, int& C) { const int st = b / 1024, sb = b % 1024, swz = sb ^ (((sb >> 9) & 1) << 5); R = (st >> 1) * 16 + swz / 64; C = (st & 1) * 32 + (swz % 64) / 2; }
__host__ __device__ __forceinline__ int perm32(int rho) { const int n = rho >> 4, i = rho & 15; return 8 * (i >> 2) + 4 * n + (i & 3); }

struct Unit { int pm, pn; };
struct Gemm { const bf16_t* A; const bf16_t* Bt; int M, N, K; };

struct StaticOrder {
    int nM, nN, nwg, G, c;
    __host__ __device__ void init(int M, int N, int G_, int c_) { nM = M / BM; nN = N / BM; nwg = nM * nN; G = G_; c = c_; }
    __host__ __device__ bool next(int i, Unit& u) const {
        const long L = (long)i * G + c; if (L >= nwg) return false;
        int wgid = (int)L; { const int q = nwg / NXCD, r = nwg % NXCD, xcd = wgid % NXCD, off = wgid / NXCD; wgid = (xcd < r ? xcd * (q + 1) : r * (q + 1) + (xcd - r) * q) + off; }
        const int nig = WGM * nN, gid = wgid / nig, fm = gid * WGM, gsz = (nM - fm) < WGM ? (nM - fm) : WGM;
        u.pm = fm + ((wgid % nig) % gsz); u.pn = (wgid % nig) / gsz; return true;
    }
    __device__ __forceinline__ void a_ready(const Unit&) const {}
    __device__ __forceinline__ void done(const Unit&) const {}
};

typedef unsigned u32x2 __attribute__((ext_vector_type(2)));
__device__ __forceinline__ unsigned cvt_pk_bf16(float lo, float hi) { return ::cvtpk(lo, hi); }
constexpr float RMS_EPS = 1e-6f;
__device__ __forceinline__ void row_rstd(const float* ssq, int row0, int fq, float (&rs)[2][4]) {
#pragma unroll
    for (int ai = 0; ai < 2; ++ai)
#pragma unroll
        for (int m = 0; m < 4; ++m) { const f32x4* p = (const f32x4*)(ssq + (size_t)(row0 + ai * HALF + m * 16) * 32 + fq * 8); const f32x4 a = p[0], b = p[1];
            float s = ((a[0] + a[1]) + (a[2] + a[3])) + ((b[0] + b[1]) + (b[2] + b[3])); s += __shfl_xor(s, 16); s += __shfl_xor(s, 32);
            rs[ai][m] = 1.0f / sqrtf(s * (1.0f / 2048.0f) + RMS_EPS); }
}
__device__ __forceinline__ void rstd_from_table(const PG8_LAS float* t, float (&rs)[2][4]) {
#pragma unroll
    for (int ai = 0; ai < 2; ++ai)
#pragma unroll
        for (int m = 0; m < 4; ++m) rs[ai][m] = t[ai * HALF + m * 16];
}
template <class Sched> __device__ __forceinline__ void fill_rstd_table(PG8_LAS float* tab, const float* ssq, const Sched& S) {
    const int tid = threadIdx.x, r = tid >> 1, hf = tid & 1; Unit u;
    for (int i = 0; S.next(i, u); ++i) { const f32x4* p = (const f32x4*)(ssq + (size_t)(u.pm * BM + r) * 32 + hf * 16); float s = 0.f;
#pragma unroll
        for (int j = 0; j < 4; ++j) { const f32x4 a = p[j]; s += (a[0] + a[1]) + (a[2] + a[3]); }
        s += __shfl_xor(s, 1);
        if (hf == 0) tab[i * 256 + r] = 1.0f / sqrtf(s * (1.0f / 2048.0f) + RMS_EPS); }
    __syncthreads();
}
struct EpiScaleBf16 {
    static constexpr bool PERM = true, AFTER_DRAIN = false;
    bf16_t* O; int ldc; const PG8_LAS float* rst;
    __device__ __forceinline__ void operator()(const f32x4 (&acc)[2][2][4][2], const Unit& u, int wr, int wc, int fr, int fq, int ui) const {
        const int row0 = u.pm * BM + wr * 64 + fr, col0 = u.pn * BM + wc * 32 + 8 * fq;
        float rs[2][4]; rstd_from_table(rst + ui * 256 + wr * 64 + fr, rs);
#pragma unroll
        for (int ai = 0; ai < 2; ++ai)
#pragma unroll
            for (int m = 0; m < 4; ++m) { bf16_t* rowp = O + (size_t)(row0 + ai * HALF + m * 16) * ldc + col0; const float r = rs[ai][m];
#pragma unroll
                for (int bj = 0; bj < 2; ++bj) { const f32x4 v0 = acc[ai][bj][m][0] * r, v1 = acc[ai][bj][m][1] * r;
                    u32x4 w; w.x = cvt_pk_bf16(v0[0], v0[1]); w.y = cvt_pk_bf16(v0[2], v0[3]); w.z = cvt_pk_bf16(v1[0], v1[1]); w.w = cvt_pk_bf16(v1[2], v1[3]);
                    *(u32x4*)(rowp + bj * HALF) = w; } }
    }
};
__device__ __forceinline__ float silu_f(float g) { return g * __builtin_amdgcn_rcpf(1.0f + __expf(-g)); }
struct EpiSwiGLU {
    static constexpr bool PERM = true, AFTER_DRAIN = false;
    bf16_t* O; int ldc; const PG8_LAS float* rst;
    __device__ __forceinline__ void operator()(const f32x4 (&acc)[2][2][4][2], const Unit& u, int wr, int wc, int fr, int fq, int ui) const {
        const int row0 = u.pm * BM + wr * 64 + fr, col0 = u.pn * HALF + wc * 32 + 8 * fq;
        float rs[2][4]; rstd_from_table(rst + ui * 256 + wr * 64 + fr, rs);
#pragma unroll
        for (int ai = 0; ai < 2; ++ai)
#pragma unroll
            for (int m = 0; m < 4; ++m) { bf16_t* rowp = O + (size_t)(row0 + ai * HALF + m * 16) * ldc + col0; const float r = rs[ai][m];
                float o[8];
#pragma unroll
                for (int n = 0; n < 2; ++n)
#pragma unroll
                    for (int e = 0; e < 4; ++e) { const float g = acc[ai][0][m][n][e] * r, up = acc[ai][1][m][n][e] * r; o[n * 4 + e] = silu_f(g) * up; }
                u32x4 w; w.x = cvt_pk_bf16(o[0], o[1]); w.y = cvt_pk_bf16(o[2], o[3]); w.z = cvt_pk_bf16(o[4], o[5]); w.w = cvt_pk_bf16(o[6], o[7]);
                *(u32x4*)rowp = w; }
    }
};
template <int MODE> struct EpiResid {
    static constexpr bool PERM = false, AFTER_DRAIN = false;
    const float* base; float* out; bf16_t* xb; float* ssq;
    __device__ __forceinline__ void operator()(const f32x4 (&acc)[2][2][4][2], const Unit& u, int wr, int wc, int fr, int fq, int) const {
        const int row0 = u.pm * BM + wr * 64 + fr, col0 = u.pn * BM + wc * 32 + 4 * fq;
#pragma unroll
        for (int ai = 0; ai < 2; ++ai)
#pragma unroll
            for (int m = 0; m < 4; ++m) { const int row = row0 + ai * HALF + m * 16; const size_t off = (size_t)row * 2048 + col0; float s = 0.f;
#pragma unroll
                for (int bj = 0; bj < 2; ++bj)
#pragma unroll
                    for (int n = 0; n < 2; ++n) { const size_t o2 = off + bj * HALF + n * 16; f32x4 bs;
                        if (MODE == 0) bs = __builtin_nontemporal_load((const f32x4*)(base + o2));
                        else { const u32x2 b2 = *(const u32x2*)(xb + o2); bs[0] = __builtin_bit_cast(float, b2.x << 16); bs[1] = __builtin_bit_cast(float, b2.x & 0xffff0000u); bs[2] = __builtin_bit_cast(float, b2.y << 16); bs[3] = __builtin_bit_cast(float, b2.y & 0xffff0000u); }
                        const f32x4 o = bs + acc[ai][bj][m][n];
                        if (MODE == 2) __builtin_nontemporal_store(o, (f32x4*)(out + o2));
                        else { s += (o[0] * o[0] + o[1] * o[1]) + (o[2] * o[2] + o[3] * o[3]); u32x2 w; w.x = cvt_pk_bf16(o[0], o[1]); w.y = cvt_pk_bf16(o[2], o[3]); *(u32x2*)(xb + o2) = w; } }
                if (MODE != 2) { s += __shfl_xor(s, 16); s += __shfl_xor(s, 32); if (fq == 0) ssq[(size_t)row * 32 + u.pn * 4 + wc] = s; } }
    }
};
template <class Epi, class Sched, bool ALIGN_EPI = false, bool SP2 = false>
__device__ __forceinline__ void gemm_phase(PG8_LAS unsigned char* lds, const Gemm g, const Sched& S, const Epi& E) {
    const int tid = opaque_tid(), wid = __builtin_amdgcn_readfirstlane(tid >> 6), lane = tid & 63, wr = wid >> 2, wc = wid & 3, fr = lane & 15, fq = lane >> 4;
    const int K = g.K, nt = K / BK;
    unsigned voffA[2], voffB[2];
#pragma unroll
    for (int i = 0; i < 2; ++i) { int R, C; stage_rc(tid * 16 + i * 8192, R, C); const int Rb = Epi::PERM ? ((R & ~31) + perm32(R & 31)) : R;
        voffA[i] = (unsigned)(R * K + C) * 2u; voffB[i] = (unsigned)(Rb * K + C) * 2u; }
    const size_t kstep = (size_t)(BK * 2);
    const size_t hstep = (size_t)HALF * K * 2;
    const size_t tstep = 2 * hstep;
    const unsigned ldsw = (unsigned)wid * 1024u;
    const int aoff = lds_byte(wr * 64 + fr, fq * 8), boff = lds_byte(wc * 32 + fr, fq * 8);
#define PG8_SA(b, h) (((b) * 2 + (h)) * HTB)
#define PG8_SB(b, h) ((4 + (b) * 2 + (h)) * HTB)
#define PG8_STAGE(bufoff, gbase, voff) do { _Pragma("unroll") for (int _i = 0; _i < 2; ++_i) \
        __builtin_amdgcn_global_load_lds((const unsigned*)((const char*)(gbase) + (voff)[_i]), (PG8_LAS unsigned*)(lds + (bufoff) + ldsw + _i * 8192), 16, 0, 0); } while (0)
#define PG8_LDA(dst, b, h) do { _Pragma("unroll") for (int m = 0; m < 4; ++m) _Pragma("unroll") for (int k = 0; k < 2; ++k) dst[m][k] = *(const PG8_LAS bf16x8*)(lds + PG8_SA(b, h) + aoff + m * 2048 + k * 1024); } while (0)
#define PG8_LDB(dst, b, h) do { _Pragma("unroll") for (int n = 0; n < 2; ++n) _Pragma("unroll") for (int k = 0; k < 2; ++k) dst[n][k] = *(const PG8_LAS bf16x8*)(lds + PG8_SB(b, h) + boff + n * 2048 + k * 1024); } while (0)
#define PG8_MMA(ai, bj, At, Bt) do { __builtin_amdgcn_s_setprio(1); _Pragma("unroll") for (int m = 0; m < 4; ++m) _Pragma("unroll") for (int n = 0; n < 2; ++n) _Pragma("unroll") for (int k = 0; k < 2; ++k) \
        acc[ai][bj][m][n] = __builtin_amdgcn_mfma_f32_16x16x32_bf16(Bt[n][k], At[m][k], acc[ai][bj][m][n], 0, 0, 0); __builtin_amdgcn_s_setprio(0); } while (0)
#define PG8_WAIT_V(n) asm volatile("s_waitcnt vmcnt(" #n ")" ::: "memory")
#define PG8_WAIT_L(n) asm volatile("s_waitcnt lgkmcnt(" #n ")" ::: "memory")
#define PG8_BAR __builtin_amdgcn_s_barrier()
#define PG8_SCHED __builtin_amdgcn_sched_barrier(0)
    Unit cur, nxt; int ui = 0;
    if (!S.next(0, cur)) return;
    f32x4 acc[2][2][4][2];
#pragma unroll
    for (int a = 0; a < 2; ++a)
#pragma unroll
        for (int b = 0; b < 2; ++b)
#pragma unroll
            for (int m = 0; m < 4; ++m)
#pragma unroll
                for (int n = 0; n < 2; ++n) acc[a][b][m][n] = (f32x4){0.f, 0.f, 0.f, 0.f};
    bf16x8 At[4][2], B0[2][2], B1[2][2];
    const char* cA = (const char*)g.A + (size_t)cur.pm * tstep; const char* cB = (const char*)g.Bt + (size_t)cur.pn * tstep;
    S.a_ready(cur);
    if constexpr (SP2) {
        PG8_STAGE(PG8_SB(0, 0), cB, voffB); PG8_STAGE(PG8_SB(0, 1), cB + hstep, voffB); PG8_STAGE(PG8_SA(0, 0), cA, voffA); PG8_STAGE(PG8_SA(0, 1), cA + hstep, voffA);
        if (wr == 1) PG8_BAR;
        PG8_WAIT_V(2); PG8_BAR;
        PG8_STAGE(PG8_SB(1, 0), cB + kstep, voffB); PG8_STAGE(PG8_SA(1, 0), cA + kstep, voffA); PG8_STAGE(PG8_SB(1, 1), cB + hstep + kstep, voffB);
        PG8_WAIT_V(6); PG8_BAR;
    } else {
        PG8_STAGE(PG8_SB(0, 0), cB, voffB); PG8_STAGE(PG8_SA(0, 0), cA, voffA); PG8_STAGE(PG8_SB(0, 1), cB + hstep, voffB); PG8_STAGE(PG8_SA(0, 1), cA + hstep, voffA);
        if (wr == 1) PG8_BAR;
        PG8_WAIT_V(4); PG8_BAR;
        PG8_STAGE(PG8_SB(1, 0), cB + kstep, voffB); PG8_STAGE(PG8_SA(1, 0), cA + kstep, voffA); PG8_STAGE(PG8_SB(1, 1), cB + hstep + kstep, voffB);
        PG8_WAIT_V(6); PG8_BAR;
    }
    for (;;) {
        const bool has_next = S.next(ui + 1, nxt);
        const char* nA = has_next ? (const char*)g.A + (size_t)nxt.pm * tstep : cA; const char* nB = has_next ? (const char*)g.Bt + (size_t)nxt.pn * tstep : cB;
        for (int t = 0; t < nt; t += 2) {
            const bool last = (t == nt - 2);
            const char* a1 = cA + (size_t)(t + 1) * kstep;
            const char* a2 = last ? nA : cA + (size_t)(t + 2) * kstep; const char* b2 = last ? nB : cB + (size_t)(t + 2) * kstep;
            const char* a3 = a2 + kstep; const char* b3 = b2 + kstep;
            if (last && has_next) S.a_ready(nxt);
            if constexpr (SP2) {
            PG8_LDB(B0, 0, 0); PG8_LDB(B1, 0, 1); PG8_SCHED; PG8_LDA(At, 0, 0); PG8_STAGE(PG8_SA(1, 1), a1 + hstep, voffA);
            PG8_WAIT_V(8); PG8_WAIT_L(0); PG8_BAR; PG8_MMA(0, 0, At, B0); PG8_MMA(0, 1, At, B1); PG8_BAR; PG8_SCHED;
            PG8_LDA(At, 0, 1); PG8_STAGE(PG8_SB(0, 0), b2, voffB); PG8_STAGE(PG8_SB(0, 1), b2 + hstep, voffB); PG8_STAGE(PG8_SA(0, 0), a2, voffA);
            PG8_WAIT_V(8); PG8_WAIT_L(0); PG8_BAR; PG8_MMA(1, 0, At, B0); PG8_MMA(1, 1, At, B1); PG8_BAR; PG8_SCHED;
            PG8_LDB(B0, 1, 0); PG8_LDB(B1, 1, 1); PG8_SCHED; PG8_LDA(At, 1, 0); PG8_STAGE(PG8_SA(0, 1), a2 + hstep, voffA);
            PG8_WAIT_V(8); PG8_WAIT_L(0); PG8_BAR; PG8_MMA(0, 0, At, B0); PG8_MMA(0, 1, At, B1); PG8_BAR; PG8_SCHED;
            PG8_LDA(At, 1, 1); PG8_STAGE(PG8_SB(1, 0), b3, voffB); PG8_STAGE(PG8_SB(1, 1), b3 + hstep, voffB); PG8_STAGE(PG8_SA(1, 0), a3, voffA);
            PG8_WAIT_V(8); PG8_WAIT_L(0); PG8_BAR; PG8_MMA(1, 0, At, B0); PG8_MMA(1, 1, At, B1); PG8_BAR; PG8_SCHED;
            } else {
            PG8_LDB(B0, 0, 0); PG8_SCHED; PG8_LDA(At, 0, 0); PG8_STAGE(PG8_SA(1, 1), a1 + hstep, voffA);
            PG8_WAIT_L(8); PG8_BAR; PG8_WAIT_L(0); PG8_MMA(0, 0, At, B0); PG8_BAR; PG8_SCHED;
            PG8_LDB(B1, 0, 1); PG8_STAGE(PG8_SB(0, 0), b2, voffB);
            PG8_BAR; PG8_WAIT_L(0); PG8_MMA(0, 1, At, B1); PG8_BAR;
            PG8_LDA(At, 0, 1); PG8_STAGE(PG8_SA(0, 0), a2, voffA);
            PG8_BAR; PG8_WAIT_L(0); PG8_MMA(1, 0, At, B0); PG8_BAR; PG8_SCHED;
            PG8_STAGE(PG8_SB(0, 1), b2 + hstep, voffB);
            PG8_WAIT_V(6); PG8_BAR; PG8_MMA(1, 1, At, B1); PG8_BAR;
            PG8_LDB(B0, 1, 0); PG8_SCHED; PG8_LDA(At, 1, 0); PG8_STAGE(PG8_SA(0, 1), a2 + hstep, voffA);
            PG8_WAIT_L(8); PG8_BAR; PG8_WAIT_L(0); PG8_MMA(0, 0, At, B0); PG8_BAR; PG8_SCHED;
            PG8_LDB(B1, 1, 1); PG8_STAGE(PG8_SB(1, 0), b3, voffB);
            PG8_BAR; PG8_WAIT_L(0); PG8_MMA(0, 1, At, B1); PG8_BAR;
            PG8_LDA(At, 1, 1); PG8_STAGE(PG8_SA(1, 0), a3, voffA);
            PG8_BAR; PG8_WAIT_L(0); PG8_MMA(1, 0, At, B0); PG8_BAR; PG8_SCHED;
            PG8_STAGE(PG8_SB(1, 1), b3 + hstep, voffB);
            PG8_WAIT_V(6); PG8_BAR; PG8_MMA(1, 1, At, B1); PG8_BAR;
            }
        }
        if constexpr (ALIGN_EPI) { if (wr == 0) PG8_BAR; }
        if constexpr (!Epi::AFTER_DRAIN) { E(acc, cur, wr, wc, fr, fq, ui); S.done(cur); }
        if (!has_next) break;
#pragma unroll
        for (int a = 0; a < 2; ++a)
#pragma unroll
            for (int b = 0; b < 2; ++b)
#pragma unroll
                for (int m = 0; m < 4; ++m)
#pragma unroll
                    for (int n = 0; n < 2; ++n) acc[a][b][m][n] = (f32x4){0.f, 0.f, 0.f, 0.f};
        cur = nxt; cA = nA; cB = nB; ++ui;
        if constexpr (ALIGN_EPI) { if (wr == 1) PG8_BAR; }
    }
    PG8_WAIT_V(0);
    if constexpr (!ALIGN_EPI) { if (wr == 0) PG8_BAR; }
    PG8_BAR;
    if constexpr (Epi::AFTER_DRAIN) { E.fused(acc, cur, wr, wc, fr, fq, lds, wid, lane); S.done(cur); }
#undef PG8_SA
#undef PG8_SB
#undef PG8_STAGE
#undef PG8_LDA
#undef PG8_LDB
#undef PG8_MMA
#undef PG8_WAIT_V
#undef PG8_WAIT_L
#undef PG8_BAR
#undef PG8_SCHED
}
}
constexpr int M = 8192, SEQ = 4096, DM = 2048, DFF = 5632;
constexpr int GLA_LD = 6160, FOX_LD = 8208;
constexpr int LD0 = 6144;
constexpr int LD1 = 8192;
constexpr int NWAVES = 8, NTHREADS = 512;
constexpr int LDS_BYTES = 151552;
constexpr size_t MiB = 1u << 20;
constexpr size_t WS_WG2 = 0, WS_BG2 = 65536, WS_OGAIN = 69632, WS_BF = 71680, WS_QGAIN = 71936, WS_KGAIN = 72448;
constexpr size_t WS_THR = 73728;
constexpr size_t WS_BAR = 131072;
constexpr size_t WS_SSQ = 1 * MiB, WS_GLR = 2 * MiB, WS_EL = 2 * MiB + 512 * 1024, WS_CF = 3 * MiB, WS_W1T = 4 * MiB, WS_WFT = 4 * MiB + 65536;
constexpr size_t WS_WGI = 8 * MiB, WS_WGO = 32 * MiB, WS_WGU0 = 40 * MiB, WS_WD0 = 84 * MiB, WS_WFI = 106 * MiB, WS_WFO = 138 * MiB, WS_WGU1 = 146 * MiB, WS_WD1 = 190 * MiB;
constexpr size_t WS_XB = 212 * MiB, WS_OB = 244 * MiB, WS_PROJ = 276 * MiB, WS_QT = 404 * MiB, WS_KDT = 420 * MiB, WS_AM = 436 * MiB, WS_ST1 = 440 * MiB, WS_END = 470 * MiB;
constexpr size_t WS_VT = WS_PROJ + 96 * MiB;
constexpr size_t WS_ST0 = WS_WGU1;

#define LAS __attribute__((address_space(3)))
typedef unsigned short bf16;
__device__ __forceinline__ bf16* st_ptr(unsigned char* ws, int pu) { return (bf16*)(ws + (pu < 392 ? WS_ST0 + (size_t)pu * 262144 : WS_ST1 + (size_t)(pu - 392) * 262144)); }
typedef unsigned v4u __attribute__((ext_vector_type(4)));
typedef unsigned v2u __attribute__((ext_vector_type(2)));
typedef float f32x4 __attribute__((ext_vector_type(4)));
typedef float f32x16 __attribute__((ext_vector_type(16)));
typedef short bf16x8 __attribute__((ext_vector_type(8)));
typedef short s16x4 __attribute__((ext_vector_type(4)));
#define SBAR() __builtin_amdgcn_sched_barrier(0)
#define LDS_WAIT() asm volatile("s_waitcnt lgkmcnt(0)" ::: "memory")
__device__ __forceinline__ unsigned f2bf(float f) { return cvtpk(f, 0.f) & 0xffffu; }
__device__ __forceinline__ unsigned pk2(float lo, float hi) { return cvtpk(lo, hi); }
__device__ __forceinline__ float bf2f(unsigned short b) { return __builtin_bit_cast(float, (unsigned)b << 16); }
__device__ __forceinline__ float wave_sum(float v) {
#pragma unroll
    for (int o = 1; o < 64; o <<= 1) v += __shfl_xor(v, o);
    return v;
}

struct Params {
    const float* x; const float* norm_mix; const float* norm_ffn; const float* gla_w_in; const float* gla_w_g2; const float* gla_b_g2; const float* gla_o_gain; const float* gla_w_o;
    const float* fox_w_in; const float* fox_b_f; const float* fox_q_gain; const float* fox_k_gain; const float* fox_w_o; const float* ffn_w_gate; const float* ffn_w_up; const float* ffn_w_down;
    float* out; unsigned char* ws; int ph_lo, ph_hi;
};

struct TJob { const float* src; const float* gain; bf16* dst; int ld, K; };
__device__ __forceinline__ void tj_load(const TJob& j, f32x4 (&v)[8]) {
#pragma unroll
    for (int r = 0; r < 8; ++r) v[r] = __builtin_nontemporal_load((const f32x4*)(j.src + (size_t)r * j.ld));
}
__device__ __forceinline__ void tj_store(const TJob& j, f32x4 (&v)[8]) {
    if (j.gain) { const f32x4 g0 = *(const f32x4*)j.gain, g1 = *(const f32x4*)(j.gain + 4);
#pragma unroll
        for (int r = 0; r < 8; ++r) v[r] = v[r] * (r < 4 ? g0[r] : g1[r - 4]); }
#pragma unroll
    for (int c = 0; c < 4; ++c) { v4u w; w.x = cvtpk(v[0][c], v[1][c]); w.y = cvtpk(v[2][c], v[3][c]); w.z = cvtpk(v[4][c], v[5][c]); w.w = cvtpk(v[6][c], v[7][c]);
        *(v4u*)(j.dst + (size_t)c * j.K) = w; }
}
__device__ __forceinline__ void p0_prologue(const Params& P, LAS unsigned char* lds, int part, int blk, int nblk_) {
    const int tid = opaque_tid(), lane = tid & 63, wave = tid >> 6;
    const int gw = blk * NWAVES + wave, NGW = nblk_ * NWAVES;
    unsigned char* ws = P.ws;
    constexpr int I_A = 32 * 192, I_B = 32 * 64, I_C = 32 * 176, I_D = 88 * 64;
    constexpr int NITEMS = 2 * I_A + 3 * I_B + 4 * I_C + 2 * I_D;
    auto decode = [&](int it) -> TJob {
        int r = it; const float* W; int ld, col0 = 0, K = 2048, nblk, mode = 0; const float* gain = nullptr; bf16* WT; int rowoff = 0;
        if (r < I_A) { W = P.gla_w_in; ld = GLA_LD; nblk = 192; gain = P.norm_mix; WT = (bf16*)(ws + WS_WGI); }
        else if ((r -= I_A) < I_B) { W = P.gla_w_o; ld = 2048; nblk = 64; WT = (bf16*)(ws + WS_WGO); }
        else if ((r -= I_B) < I_C) { W = P.ffn_w_gate; ld = DFF; nblk = 176; gain = P.norm_ffn; WT = (bf16*)(ws + WS_WGU0); mode = 1; }
        else if ((r -= I_C) < I_C) { W = P.ffn_w_up; ld = DFF; nblk = 176; gain = P.norm_ffn; WT = (bf16*)(ws + WS_WGU0); mode = 1; rowoff = 128; }
        else if ((r -= I_C) < I_D) { W = P.ffn_w_down; ld = 2048; nblk = 64; K = DFF; WT = (bf16*)(ws + WS_WD0); }
        else if ((r -= I_D) < I_A) { W = P.fox_w_in; ld = FOX_LD; nblk = 192; gain = P.norm_mix + DM; WT = (bf16*)(ws + WS_WFI); }
        else if ((r -= I_A) < I_B) { W = P.fox_w_in; ld = FOX_LD; col0 = 6160; nblk = 64; gain = P.norm_mix + DM; WT = (bf16*)(ws + WS_WFI); rowoff = 6144; }
        else if ((r -= I_B) < I_B) { W = P.fox_w_o; ld = 2048; nblk = 64; WT = (bf16*)(ws + WS_WFO); }
        else if ((r -= I_B) < I_C) { W = P.ffn_w_gate + (size_t)DM * DFF; ld = DFF; nblk = 176; gain = P.norm_ffn + DM; WT = (bf16*)(ws + WS_WGU1); mode = 1; }
        else if ((r -= I_C) < I_C) { W = P.ffn_w_up + (size_t)DM * DFF; ld = DFF; nblk = 176; gain = P.norm_ffn + DM; WT = (bf16*)(ws + WS_WGU1); mode = 1; rowoff = 128; }
        else { r -= I_C; W = P.ffn_w_down + (size_t)DFF * DM; ld = 2048; nblk = 64; K = DFF; WT = (bf16*)(ws + WS_WD1); }
        const int kb = r / nblk, nb = r % nblk, n0 = nb * 32, k0 = kb * 64 + 8 * (lane >> 3), c4 = lane & 7;
        const int drow0 = (mode ? ((n0 >> 7) * 256 + (n0 & 127)) : n0) + rowoff;
        TJob j; j.src = W + (size_t)k0 * ld + col0 + n0 + 4 * c4; j.gain = gain ? gain + k0 : nullptr; j.dst = WT + (size_t)(drow0 + 4 * c4) * K + k0; j.ld = ld; j.K = K; return j;
    };
    constexpr int NITEMS_A = I_A + I_B + 2 * I_C + I_D + I_A, NITEMS_B = NITEMS_A + 2 * I_B + 2 * I_C;
    const int it_lo = part == 0 ? 0 : (part == 1 ? NITEMS_A : NITEMS_B), it_hi = part == 0 ? NITEMS_A : (part == 1 ? NITEMS_B : NITEMS);
    if (part == 0) {
    bf16* XB = (bf16*)(ws + WS_XB); float* SSQ = (float*)(ws + WS_SSQ);
    for (int m = gw; m < M; m += NGW) {
        const f32x4* xr = (const f32x4*)(P.x + (size_t)m * DM) + lane; f32x4 v[8]; float s = 0.f;
#pragma unroll
        for (int j = 0; j < 8; ++j) { v[j] = __builtin_nontemporal_load(xr + 64 * j); s += (v[j][0] * v[j][0] + v[j][1] * v[j][1]) + (v[j][2] * v[j][2] + v[j][3] * v[j][3]); }
        s = wave_sum(s);
        v2u* o8 = (v2u*)(XB + (size_t)m * DM) + lane;
#pragma unroll
        for (int j = 0; j < 8; ++j) { v2u w; w.x = pk2(v[j][0], v[j][1]); w.y = pk2(v[j][2], v[j][3]); o8[64 * j] = w; }
        if (lane < 32) SSQ[(size_t)m * 32 + lane] = lane == 0 ? s : 0.f;
    }
    }
    { int it = it_lo + gw;
      if (it < it_hi) {
        bool h1 = it + NGW < it_hi; TJob j0 = decode(it), j1 = decode(h1 ? it + NGW : it);
        f32x4 va[8], vb[8]; tj_load(j0, va); tj_load(j1, vb);
        for (;;) {
            const int itn = it + 2 * NGW; const bool more = itn < it_hi;
            const bool h1n = more && (itn + NGW < it_hi);
            const TJob n0 = decode(more ? itn : it), n1 = decode(h1n ? itn + NGW : (more ? itn : it));
            f32x4 vc[8], vd[8];
            if (more) { tj_load(n0, vc); tj_load(n1, vd); }
            tj_store(j0, va); if (h1) tj_store(j1, vb);
            if (!more) break;
#pragma unroll
            for (int r = 0; r < 8; ++r) { va[r] = vc[r]; vb[r] = vd[r]; }
            j0 = n0; j1 = n1; h1 = h1n; it = itn;
        }
      } }
    if (part) return;
    for (int e = blockIdx.x * NTHREADS + tid; e < 65536; e += gridDim.x * NTHREADS) {
        const int which = e >> 15, idx = e & 32767, k = idx >> 4, c = idx & 15;
        const float v = which ? P.fox_w_in[(size_t)k * FOX_LD + 6144 + c] * P.norm_mix[DM + k] : P.gla_w_in[(size_t)k * GLA_LD + 6144 + c] * P.norm_mix[k];
        ((bf16*)(ws + (which ? WS_WFT : WS_W1T)))[c * 2048 + k] = (bf16)f2bf(v);
    }
    for (int e = blockIdx.x * NTHREADS + tid; e < 16384 + 1024 + 512 + 16 + 128 + 128; e += gridDim.x * NTHREADS) {
        if (e < 16384) ((float*)(ws + WS_WG2))[e] = P.gla_w_g2[e];
        else if (e < 17408) ((float*)(ws + WS_BG2))[e - 16384] = P.gla_b_g2[e - 16384];
        else if (e < 17920) ((float*)(ws + WS_OGAIN))[e - 17408] = P.gla_o_gain[e - 17408];
        else if (e < 17936) ((float*)(ws + WS_BF))[e - 17920] = P.fox_b_f[e - 17920];
        else if (e < 18064) ((float*)(ws + WS_QGAIN))[e - 17936] = P.fox_q_gain[e - 17936];
        else ((float*)(ws + WS_KGAIN))[e - 18064] = P.fox_k_gain[e - 18064];
    }
}

__device__ __forceinline__ void thin_gemm(const bf16* XB, const bf16* WT, const float* SSQ, float* OUT, LAS unsigned char* lds) {
    const int tid = opaque_tid(), lane = tid & 63, wave = tid >> 6, fr = lane & 15, q = lane >> 4, grp = wave >> 2, wk = wave & 3;
    LAS f32x4* red = (LAS f32x4*)lds;
    for (int t0 = 2 * blockIdx.x; t0 < M / 16; t0 += 2 * gridDim.x) { const int tile = t0 + grp;
        f32x4 acc = {0.f, 0.f, 0.f, 0.f};
        const bf16* ap = XB + (size_t)(tile * 16 + fr) * DM + wk * 512 + q * 8; const bf16* bp = WT + (size_t)fr * DM + wk * 512 + q * 8;
        float t4[4] = {0.f, 0.f, 0.f, 0.f};
        if (wk == 0) {
#pragma unroll
            for (int i = 0; i < 4; ++i) { const f32x4* p = (const f32x4*)(SSQ + (size_t)(tile * 16 + 4 * q + i) * 32);
#pragma unroll
                for (int j = 0; j < 8; ++j) { const f32x4 a = p[j]; t4[i] += (a[0] + a[1]) + (a[2] + a[3]); } } }
#pragma unroll
        for (int kb = 0; kb < 16; ++kb) { const bf16x8 a = *(const bf16x8*)(ap + kb * 32), b = *(const bf16x8*)(bp + kb * 32); acc = __builtin_amdgcn_mfma_f32_16x16x32_bf16(a, b, acc, 0, 0, 0); }
        red[wave * 64 + lane] = acc;
        __syncthreads();
        if (wk == 0) {
            f32x4 s = red[wave * 64 + lane];
#pragma unroll
            for (int w = 1; w < 4; ++w) s += red[(wave + w) * 64 + lane];
#pragma unroll
            for (int i = 0; i < 4; ++i) OUT[(size_t)(tile * 16 + 4 * q + i) * 16 + fr] = s[i] / sqrtf(t4[i] * (1.0f / 2048.0f) + 1e-6f);
        }
        __syncthreads();
    }
}
__device__ __forceinline__ float log_sigmoid_f(float z) { return fminf(z, 0.f) - __logf(1.0f + __expf(-fabsf(z))); }
__device__ __forceinline__ void gla_prep_unit(const Params& P, LAS unsigned char* lds, int u) {
    const int tid = opaque_tid(), lane = tid & 63, wave = tid >> 6, fr = lane & 15, q4 = lane >> 4;
    const int ch = u & 63, h = (u >> 6) & 3, b = u >> 8, tok0 = b * SEQ + ch * 64;
    unsigned char* ws = P.ws;
    LAS float* Bs = (LAS float*)lds;
    LAS bf16* QS = (LAS bf16*)(lds + 65536);
    LAS bf16* KS = (LAS bf16*)(lds + 65536 + 33792);
    LAS float* GL = (LAS float*)(lds + 133120);
    LAS float* TOT = (LAS float*)(lds + 137216);
    const float* GLR = (const float*)(ws + WS_GLR); const bf16* PROJ = (const bf16*)(ws + WS_PROJ);
    bf16* QT = (bf16*)(ws + WS_QT); bf16* KDT = (bf16*)(ws + WS_KDT); bf16* AM = (bf16*)(ws + WS_AM); float* EL = (float*)(ws + WS_EL);
    v4u rq[4], rk[4];
#pragma unroll
    for (int it = 0; it < 4; ++it) { const int idx = it * NTHREADS + tid, t = idx >> 5, cc = idx & 31; const bf16* p = PROJ + (size_t)(tok0 + t) * LD0 + 256 * h + 8 * cc; rq[it] = __builtin_nontemporal_load((const v4u*)p); rk[it] = __builtin_nontemporal_load((const v4u*)(p + 1024)); }
    if (tid < 256) ((LAS f32x4*)GL)[tid] = ((const f32x4*)(GLR + (size_t)tok0 * 16))[tid];
    const int c = tid & 255, th = tid >> 8;
    float w2[16];
#pragma unroll
    for (int j = 0; j < 16; ++j) w2[j] = ((const float*)(ws + WS_WG2))[j * 1024 + 256 * h + c];
    const float bias = ((const float*)(ws + WS_BG2))[256 * h + c];
    __syncthreads();
    float cum = 0.f;
#pragma unroll 4
    for (int tt = 0; tt < 32; ++tt) { const int t = 32 * th + tt; float z = bias;
#pragma unroll
        for (int j = 0; j < 16; ++j) z += GL[t * 16 + j] * w2[j];
        cum += log_sigmoid_f(z) * (1.0f / 16.0f); Bs[t * 256 + c] = cum; }
    TOT[th * 256 + c] = cum;
#pragma unroll
    for (int it = 0; it < 4; ++it) { const int idx = it * NTHREADS + tid, t = idx >> 5, cc = idx & 31; *(LAS v4u*)(QS + t * 264 + 8 * cc) = rq[it]; *(LAS v4u*)(KS + t * 264 + 8 * cc) = rk[it]; }
    v4u rv[8];
#pragma unroll
    for (int it = 0; it < 8; ++it) { const int idx = it * NTHREADS + tid, t = idx >> 6, cc = idx & 63; rv[it] = __builtin_nontemporal_load((const v4u*)(PROJ + (size_t)(tok0 + t) * LD0 + 2048 + 512 * h + 8 * cc)); }
    __syncthreads();
    const float off = th ? TOT[c] : 0.f, blast = TOT[c] + TOT[256 + c], eblast = __expf(blast);
    for (int g8 = 0; g8 < 4; ++g8) { unsigned kdp[8];
#pragma unroll
        for (int e = 0; e < 8; ++e) { const int t = 32 * th + g8 * 8 + e; const float bb = Bs[t * 256 + c] + off;
            const float qv = bf2f(QS[t * 264 + c]), kv = bf2f(KS[t * 264 + c]);
            const float eb = __expf(bb), qt = qv * 0.0625f * eb, kt = kv * __expf(-bb), kd = kt * eblast;
            QS[t * 264 + c] = (bf16)f2bf(qt); KS[t * 264 + c] = (bf16)f2bf(kt); kdp[e] = f2bf(kd); }
        v4u o; o.x = kdp[0] | (kdp[1] << 16); o.y = kdp[2] | (kdp[3] << 16); o.z = kdp[4] | (kdp[5] << 16); o.w = kdp[6] | (kdp[7] << 16);
        *(v4u*)(KDT + ((size_t)u * 256 + c) * 64 + 32 * th + g8 * 8) = o; }
    if (th == 0) EL[(size_t)u * 256 + c] = eblast;
    __syncthreads();
    LAS bf16* VS = (LAS bf16*)lds;
#pragma unroll
    for (int it = 0; it < 8; ++it) { const int idx = it * NTHREADS + tid, t = idx >> 6, cc = idx & 63; *(LAS v4u*)(VS + t * 512 + 8 * (cc ^ ((t >> 3) & 7))) = rv[it]; }
#pragma unroll
    for (int it = 0; it < 4; ++it) { const int idx = it * NTHREADS + tid, t = idx >> 5, cc = idx & 31; *(v4u*)(QT + ((size_t)u * 64 + t) * 256 + 8 * cc) = *(const LAS v4u*)(QS + t * 264 + 8 * cc); }
#pragma unroll
    for (int rep = 0; rep < 2; ++rep) { const int idx = wave + 8 * rep, mi = idx >> 2, si = idx & 3;
        f32x4 acc = {0.f, 0.f, 0.f, 0.f};
        if (si <= mi) {
#pragma unroll
            for (int kb = 0; kb < 8; ++kb) { const bf16x8 a = *(const LAS bf16x8*)(KS + (16 * si + fr) * 264 + 32 * kb + 8 * q4), bq = *(const LAS bf16x8*)(QS + (16 * mi + fr) * 264 + 32 * kb + 8 * q4);
                acc = __builtin_amdgcn_mfma_f32_16x16x32_bf16(a, bq, acc, 0, 0, 0); }
        }
        const int t = 16 * mi + fr; float o4[4];
#pragma unroll
        for (int i = 0; i < 4; ++i) { const int s = 16 * si + 4 * q4 + i; o4[i] = (s <= t) ? acc[i] : 0.f; }
        v2u w; w.x = pk2(o4[0], o4[1]); w.y = pk2(o4[2], o4[3]);
        *(v2u*)(AM + ((size_t)u * 64 + t) * 64 + 16 * si + 4 * q4) = w; }
    __syncthreads();
    { const int vv = lane >> 3, tc = lane & 7;
#pragma unroll
      for (int i = 0; i < 8; ++i) { const int v = 64 * wave + 8 * i + vv; const LAS bf16* src = VS + (8 * tc) * 512 + (((v >> 3) ^ tc) * 8) + (v & 7); unsigned e[8];
#pragma unroll
          for (int j = 0; j < 8; ++j) e[j] = src[j * 512];
          v4u o; o.x = e[0] | (e[1] << 16); o.y = e[2] | (e[3] << 16); o.z = e[4] | (e[5] << 16); o.w = e[6] | (e[7] << 16);
          *(v4u*)((bf16*)(ws + WS_VT) + ((size_t)u * 512 + v) * 64 + 8 * tc) = o; } }
    __syncthreads();
}
__device__ __forceinline__ void gla_scan_unit(const Params& P, LAS unsigned char* lds, int u) {
    const int tid = opaque_tid(), lane = tid & 63, wave = tid >> 6, fr = lane & 15, q4 = lane >> 4;
    const int bh = u >> 5, kblk = (u >> 3) & 3, vblk = u & 7, pu0 = bh * 64;
    unsigned char* ws = P.ws;
    const bf16* kdsrc = (const bf16*)(ws + WS_KDT) + ((size_t)pu0 * 256 + 64 * kblk) * 64 + tid * 8;
    const bf16* vtsrc = (const bf16*)(ws + WS_VT) + ((size_t)pu0 * 512 + 64 * vblk) * 64 + tid * 8;
    const float* elsrc = (const float*)(ws + WS_EL) + (size_t)pu0 * 256 + 64 * kblk + 4 * (tid & 15) + (tid >> 4) * 256;
    const int wofs = (tid >> 3) * 144 + (tid & 7) * 16;
    const int kt = wave >> 1, key0 = 64 * kblk + 16 * kt, v0 = 64 * vblk + 32 * (wave & 1);
    const int kdo = (16 * kt + fr) * 144 + q4 * 16, vfo = 9216 + (32 * (wave & 1) + fr) * 144 + q4 * 16, elo = 147456 + (16 * kt + 4 * q4) * 4;
    v4u rk[8], rv[8]; f32x4 re = {0.f, 0.f, 0.f, 0.f};
#define SC_ISSUE(bt) do { _Pragma("unroll") for (int s = 0; s < 8; ++s) { rk[s] = *(const v4u*)(kdsrc + (size_t)((bt) * 8 + s) * 16384); rv[s] = *(const v4u*)(vtsrc + (size_t)((bt) * 8 + s) * 32768); } \
        if (tid < 128) re = *(const f32x4*)(elsrc + (bt) * 2048); } while (0)
#define SC_COMMIT() do { _Pragma("unroll") for (int s = 0; s < 8; ++s) { *(LAS v4u*)(lds + s * 18432 + wofs) = rk[s]; *(LAS v4u*)(lds + s * 18432 + 9216 + wofs) = rv[s]; } \
        if (tid < 128) *(LAS f32x4*)(lds + 147456 + tid * 16) = re; } while (0)
    f32x4 T0 = {0.f, 0.f, 0.f, 0.f}, T1 = {0.f, 0.f, 0.f, 0.f};
    SC_ISSUE(0); SC_COMMIT();
    __syncthreads();
    for (int bt = 0; bt < 8; ++bt) {
        if (bt + 1 < 8) SC_ISSUE(bt + 1);
#pragma unroll
        for (int s = 0; s < 8; ++s) {
            bf16* st = st_ptr(ws, pu0 + bt * 8 + s) + ((size_t)(key0 >> 4) * 512 + v0 + fr) * 16 + 4 * q4;
            { v2u w; w.x = cvtpk(T0[0], T0[1]); w.y = cvtpk(T0[2], T0[3]); *(v2u*)st = w; w.x = cvtpk(T1[0], T1[1]); w.y = cvtpk(T1[2], T1[3]); *(v2u*)(st + 16 * 16) = w; }
            const f32x4 el = *(const LAS f32x4*)(lds + elo + s * 256);
            T0 = T0 * el; T1 = T1 * el;
#pragma unroll
            for (int kb = 0; kb < 2; ++kb) { const bf16x8 kd = *(const LAS bf16x8*)(lds + s * 18432 + kdo + kb * 64);
                const bf16x8 v0f = *(const LAS bf16x8*)(lds + s * 18432 + vfo + kb * 64), v1f = *(const LAS bf16x8*)(lds + s * 18432 + vfo + 16 * 144 + kb * 64);
                T0 = __builtin_amdgcn_mfma_f32_16x16x32_bf16(kd, v0f, T0, 0, 0, 0); T1 = __builtin_amdgcn_mfma_f32_16x16x32_bf16(kd, v1f, T1, 0, 0, 0); }
        }
        __syncthreads();
        if (bt + 1 < 8) SC_COMMIT();
        __syncthreads();
    }
#undef SC_ISSUE
#undef SC_COMMIT
}
__device__ __forceinline__ void gla_out_unit(const Params& P, LAS unsigned char* lds, int u) {
    const int tid = opaque_tid(), lane = tid & 63, wave = tid >> 6, fr = lane & 15, q4 = lane >> 4;
    const int ch = u & 63, h = (u >> 6) & 3, b = u >> 8, tok0 = b * SEQ + ch * 64;
    unsigned char* ws = P.ws;
    const bf16* PROJ = (const bf16*)(ws + WS_PROJ); const bf16* QT = (const bf16*)(ws + WS_QT); const bf16* AM = (const bf16*)(ws + WS_AM); const bf16* VT = (const bf16*)(ws + WS_VT);
    bf16* OB = (bf16*)(ws + WS_OB); const bf16* ST = st_ptr(ws, u);
    LAS bf16* QS = (LAS bf16*)lds;
    LAS bf16* AS = (LAS bf16*)(lds + 33792);
    LAS float* SS = (LAS float*)(lds + 33792 + 9216);
    LAS float* RS = (LAS float*)(lds + 33792 + 9216 + 2048);
#pragma unroll
    for (int it = 0; it < 4; ++it) { const int idx = it * NTHREADS + tid, t = idx >> 5, cc = idx & 31; *(LAS v4u*)(QS + t * 264 + 8 * cc) = *(const v4u*)(QT + ((size_t)u * 64 + t) * 256 + 8 * cc); }
    { const int t = tid >> 3, cc = tid & 7; *(LAS v4u*)(AS + t * 72 + 8 * cc) = *(const v4u*)(AM + ((size_t)u * 64 + t) * 64 + 8 * cc); }
    LAS bf16* RT = (LAS bf16*)(lds + 49152);
#pragma unroll
    for (int it = 0; it < 8; ++it) { const int idx = it * NTHREADS + tid, t = idx >> 6, cc = idx & 63; const v4u rv = *(const v4u*)(PROJ + (size_t)(tok0 + t) * LD0 + 4096 + 512 * h + 8 * cc);
        LAS v2u* d = (LAS v2u*)(RT + t * 516 + 8 * cc); d[0] = (v2u){rv.x, rv.y}; d[1] = (v2u){rv.z, rv.w}; }
    __syncthreads();
    f32x4 acc[4][4];
#pragma unroll
    for (int m = 0; m < 4; ++m)
#pragma unroll
        for (int j = 0; j < 4; ++j) acc[m][j] = (f32x4){0.f, 0.f, 0.f, 0.f};
    const bf16* stp = ST + ((size_t)(q4 >> 1) * 512 + 64 * wave + fr) * 16 + 8 * (q4 & 1); const bf16* vtp = VT + ((size_t)u * 512 + 64 * wave + fr) * 64 + 8 * q4;
#pragma unroll
    for (int kb = 0; kb < 10; ++kb) { bf16x8 bfr[4], afr[4];
#pragma unroll
        for (int j = 0; j < 4; ++j) bfr[j] = kb < 8 ? __builtin_nontemporal_load((const bf16x8*)(stp + (size_t)(2 * kb) * 8192 + 16 * j * 16)) : *(const bf16x8*)(vtp + (size_t)(16 * j) * 64 + 32 * (kb - 8));
#pragma unroll
        for (int m = 0; m < 4; ++m) afr[m] = kb < 8 ? *(const LAS bf16x8*)(QS + (16 * m + fr) * 264 + 32 * kb + 8 * q4) : *(const LAS bf16x8*)(AS + (16 * m + fr) * 72 + 32 * (kb - 8) + 8 * q4);
#pragma unroll
        for (int m = 0; m < 4; ++m)
#pragma unroll
            for (int j = 0; j < 4; ++j) acc[m][j] = __builtin_amdgcn_mfma_f32_16x16x32_bf16(afr[m], bfr[j], acc[m][j], 0, 0, 0); }
#pragma unroll
    for (int m = 0; m < 4; ++m)
#pragma unroll
        for (int i = 0; i < 4; ++i) { float s = 0.f;
#pragma unroll
            for (int j = 0; j < 4; ++j) s += acc[m][j][i] * acc[m][j][i];
            s += __shfl_xor(s, 1); s += __shfl_xor(s, 2); s += __shfl_xor(s, 4); s += __shfl_xor(s, 8);
            if (fr == 0) SS[wave * 64 + 16 * m + 4 * q4 + i] = s; }
    __syncthreads();
    if (tid < 64) { float s = 0.f;
#pragma unroll
        for (int w = 0; w < 8; ++w) s += SS[w * 64 + tid];
        RS[tid] = 1.0f / sqrtf(s * (1.0f / 512.0f) + 1e-6f); }
    __syncthreads();
    const float* ogn = (const float*)(ws + WS_OGAIN); float gn[4];
#pragma unroll
    for (int j = 0; j < 4; ++j) gn[j] = ogn[64 * wave + 16 * j + fr];
#pragma unroll
    for (int m = 0; m < 4; ++m) { const f32x4 rs4 = *(const LAS f32x4*)(RS + 16 * m + 4 * q4);
#pragma unroll
        for (int i = 0; i < 4; ++i) { const int t = 16 * m + 4 * q4 + i; LAS bf16* rp = RT + t * 516 + 64 * wave + fr;
#pragma unroll
            for (int j = 0; j < 4; ++j) { const float r = bf2f(rp[16 * j]); rp[16 * j] = (bf16)f2bf(acc[m][j][i] * rs4[i] * gn[j] * (r / (1.0f + __expf(-r)))); } }
        SBAR(); }
    __syncthreads();
#pragma unroll
    for (int it = 0; it < 16; ++it) { const int idx = it * NTHREADS + tid, t = idx >> 7, cc = idx & 127; *(v2u*)(OB + (size_t)(tok0 + t) * DM + 512 * h + 4 * cc) = *(const LAS v2u*)(RT + t * 516 + 4 * cc); }
    __syncthreads();
}
constexpr float LOG2E = 1.4426950408889634f;
__device__ __forceinline__ void fox_prep(const Params& P, LAS unsigned char* lds) {
    const int tid = opaque_tid(), lane = tid & 63, wave = tid >> 6;
    unsigned char* ws = P.ws;
    const float* qgn = (const float*)(ws + WS_QGAIN); const float* kgn = (const float*)(ws + WS_KGAIN);
    const float qs = 0.08838834764831845f * LOG2E;
    if (blockIdx.x == 0 && wave == 0) { float mq = 0.f, mk = 0.f;
        for (int i = lane; i < 128; i += 64) { mq = fmaxf(mq, fabsf(qgn[i])); mk = fmaxf(mk, fabsf(kgn[i])); }
#pragma unroll
        for (int o = 1; o < 64; o <<= 1) { mq = fmaxf(mq, __shfl_xor(mq, o)); mk = fmaxf(mk, __shfl_xor(mk, o)); }
        if (lane == 0) *(float*)(ws + WS_THR) = 2.0f * (128.0f * mq * mk * qs * 1.05f) + 130.0f; }
    const float* FLR = (const float*)(ws + WS_GLR); float* CF = (float*)(ws + WS_CF);
    for (int sq = blockIdx.x; sq < 32; sq += gridDim.x) { const int b = sq >> 4, h = sq & 15; const float bf = ((const float*)(ws + WS_BF))[h];
        float v[8]; float cum = 0.f;
#pragma unroll
        for (int i = 0; i < 8; ++i) v[i] = FLR[(size_t)(b * SEQ + tid * 8 + i) * 16 + h];
#pragma unroll
        for (int i = 0; i < 8; ++i) { const float z = v[i] + bf; cum += fminf(z, 0.f) - log1pf(expf(-fabsf(z))); v[i] = cum; }
        float incl = cum;
#pragma unroll
        for (int o = 1; o < 64; o <<= 1) { const float t = __shfl_up(incl, o); if (lane >= o) incl += t; }
        LAS float* wt = (LAS float*)lds;
        if (lane == 63) wt[wave] = incl;
        __syncthreads();
        float woff = 0.f;
#pragma unroll
        for (int w = 0; w < 8; ++w) woff += (w < wave) ? wt[w] : 0.f;
        const float excl = woff + incl - cum;
        f32x4 o0, o1;
#pragma unroll
        for (int i = 0; i < 4; ++i) { o0[i] = (v[i] + excl) * LOG2E; o1[i] = (v[4 + i] + excl) * LOG2E; }
        f32x4* dst = (f32x4*)(CF + (size_t)sq * SEQ + tid * 8); dst[0] = o0; dst[1] = o1;
        __syncthreads();
    }
}
#define KSWZ(row, colB) ((row) * 256 + ((colB) ^ (((row) & 7) << 4)))
constexpr int SHM_K = 16384, SHM_V = 16384;
__device__ __forceinline__ int v_st(int k, int c) { const int kk = (k & ~0xC) | ((k & 4) << 1) | ((k & 8) >> 1); return ((kk >> 3) * 4 + (c >> 5)) * 512 + ((kk & 7) * 32 + (c & 31)) * 2; }
__device__ __forceinline__ int v_rd_base(int lane) { return ((lane & 3) << 3) | (((lane >> 2) & 3) << 6) | (((lane >> 4) & 1) << 5) | (((lane >> 5) & 1) << 8); }
constexpr int v_rd_off(int d0, int ks, int half) { return d0 * 512 + ks * 4096 + half * 2048; }
__device__ __forceinline__ int crow(int r, int hi) { return (r & 3) + 8 * (r >> 2) + 4 * hi; }
template <int KB>
__device__ __forceinline__ void qkt(f32x16& p0, f32x16& p1, const char* K_lds, int r32, int hi, const bf16x8* qs) {
    p0 = f32x16{}; p1 = f32x16{};
    const char* kb[4];
#pragma unroll
    for (int dd = 0; dd < 4; ++dd) kb[dd] = K_lds + KB * SHM_K + KSWZ(r32, (dd * 16 + hi * 8) * 2);
#pragma unroll
    for (int d0 = 0; d0 < 8; ++d0) { const char* a = kb[d0 & 3] + (d0 >> 2) * 128;
        bf16x8 b0 = *reinterpret_cast<const bf16x8*>(a);
        bf16x8 b1 = *reinterpret_cast<const bf16x8*>(a + 32 * 256);
        const bf16x8 qf = qs[d0 * 64];
        p0 = __builtin_amdgcn_mfma_f32_32x32x16_bf16(b0, qf, p0, 0, 0, 0);
        p1 = __builtin_amdgcn_mfma_f32_32x32x16_bf16(b1, qf, p1, 0, 0, 0); }
}
template <int VB>
__device__ __forceinline__ void pv_tile(f32x16* o, int vb0, bf16x8 pa0, bf16x8 pa1, bf16x8 pa2, bf16x8 pa3) {
#define TRRD(dst, off) asm volatile("ds_read_b64_tr_b16 %0, %1 offset:%2" : "=&v"(dst) : "v"(vb0), "i"(off) : "memory")
#define PV_RD(S, d0) do { constexpr int b_ = VB * SHM_V + v_rd_off(d0, 0, 0); \
        TRRD(S##l0, b_); TRRD(S##h0, b_ + 2048); TRRD(S##l1, b_ + 4096); TRRD(S##h1, b_ + 6144); TRRD(S##l2, b_ + 8192); TRRD(S##h2, b_ + 10240); TRRD(S##l3, b_ + 12288); TRRD(S##h3, b_ + 14336); } while (0)
#define PV_WAIT(n) do { asm volatile("s_waitcnt lgkmcnt(%0)" :: "i"(n) : "memory"); SBAR(); } while (0)
#define PV_MM(S, d0) do { \
        o[d0] = __builtin_amdgcn_mfma_f32_32x32x16_bf16(pa0, (bf16x8){S##l0[0], S##l0[1], S##l0[2], S##l0[3], S##h0[0], S##h0[1], S##h0[2], S##h0[3]}, o[d0], 0, 0, 0); \
        o[d0] = __builtin_amdgcn_mfma_f32_32x32x16_bf16(pa1, (bf16x8){S##l1[0], S##l1[1], S##l1[2], S##l1[3], S##h1[0], S##h1[1], S##h1[2], S##h1[3]}, o[d0], 0, 0, 0); \
        o[d0] = __builtin_amdgcn_mfma_f32_32x32x16_bf16(pa2, (bf16x8){S##l2[0], S##l2[1], S##l2[2], S##l2[3], S##h2[0], S##h2[1], S##h2[2], S##h2[3]}, o[d0], 0, 0, 0); \
        o[d0] = __builtin_amdgcn_mfma_f32_32x32x16_bf16(pa3, (bf16x8){S##l3[0], S##l3[1], S##l3[2], S##l3[3], S##h3[0], S##h3[1], S##h3[2], S##h3[3]}, o[d0], 0, 0, 0); SBAR(); } while (0)
    s16x4 Al0, Al1, Al2, Al3, Ah0, Ah1, Ah2, Ah3, Bl0, Bl1, Bl2, Bl3, Bh0, Bh1, Bh2, Bh3;
    PV_RD(A, 0); PV_RD(B, 1); PV_WAIT(8); PV_MM(A, 0);
    PV_RD(A, 2); PV_WAIT(8); PV_MM(B, 1);
    PV_RD(B, 3); PV_WAIT(8); PV_MM(A, 2);
    PV_WAIT(0); PV_MM(B, 3);
#undef PV_RD
#undef PV_WAIT
#undef PV_MM
#undef TRRD
}
__device__ __forceinline__ bf16x8 knorm8(bf16x8 x, const float* g) {
    const v4u xv = __builtin_bit_cast(v4u, x); float f[8];
#pragma unroll
    for (int e = 0; e < 4; ++e) { f[2 * e] = __builtin_bit_cast(float, xv[e] << 16); f[2 * e + 1] = __builtin_bit_cast(float, xv[e] & 0xffff0000u); }
    float s = 0.f;
#pragma unroll
    for (int e = 0; e < 8; ++e) s += f[e] * f[e];
    s += __shfl_xor(s, 1); s += __shfl_xor(s, 2); s += __shfl_xor(s, 4); s += __shfl_xor(s, 8);
    const float r = 1.0f / sqrtf(s * (1.0f / 128.0f) + 1e-6f);
    const f32x4 g0 = *(const f32x4*)g, g1 = *(const f32x4*)(g + 4);
    v4u w; w.x = cvtpk(f[0] * r * g0[0], f[1] * r * g0[1]); w.y = cvtpk(f[2] * r * g0[2], f[3] * r * g0[3]); w.z = cvtpk(f[4] * r * g1[0], f[5] * r * g1[1]); w.w = cvtpk(f[6] * r * g1[2], f[7] * r * g1[3]);
    return __builtin_bit_cast(bf16x8, w);
}
template <int BUF>
__device__ __forceinline__ void fox_tile(f32x16* o, float& m_reg, float& l_reg, const char* lds, const float* ckl, float* al_l, int vb0, const bf16x8* qr, float cq, int qpos, int kb0, bool need_mask, int r32, int hi) {
    f32x16 p0, p1;
    qkt<BUF>(p0, p1, lds + 2 * SHM_V, r32, hi, qr);
    const float* ck = ckl + kb0 + 4 * hi;
#pragma unroll
    for (int g = 0; g < 4; ++g) { const f32x4 c0 = *(const f32x4*)(ck + 8 * g), c1 = *(const f32x4*)(ck + 32 + 8 * g);
#pragma unroll
        for (int e = 0; e < 4; ++e) { p0[4 * g + e] += cq - c0[e]; p1[4 * g + e] += cq - c1[e]; } }
    if (need_mask) { const float NEG = -__builtin_inff(); const int dq = qpos - kb0 - 4 * hi;
#pragma unroll
        for (int r = 0; r < 16; ++r) { const int c = (r & 3) + 8 * (r >> 2); if (c > dq) p0[r] = NEG; if (c + 32 > dq) p1[r] = NEG; } }
    float pmax = p0[0];
#pragma unroll
    for (int r = 1; r < 16; ++r) pmax = fmaxf(pmax, p0[r]);
#pragma unroll
    for (int r = 0; r < 16; ++r) pmax = fmaxf(pmax, p1[r]);
    { auto rr = __builtin_amdgcn_permlane32_swap(__float_as_uint(pmax), __float_as_uint(pmax), false, false); pmax = fmaxf(__uint_as_float(rr[0]), __uint_as_float(rr[1])); }
    const float mn = fmaxf(m_reg, pmax), alpha = __builtin_amdgcn_exp2f(m_reg - mn); m_reg = mn;
    float ps = 0.f;
#pragma unroll
    for (int r = 0; r < 16; ++r) { p0[r] = __builtin_amdgcn_exp2f(p0[r] - mn); p1[r] = __builtin_amdgcn_exp2f(p1[r] - mn); ps += p0[r] + p1[r]; }
    { auto rr = __builtin_amdgcn_permlane32_swap(__float_as_uint(ps), __float_as_uint(ps), false, false); ps = __uint_as_float(rr[0]) + __uint_as_float(rr[1]); }
    l_reg = l_reg * alpha + ps;
    bf16x8 pa0, pa1, pa2, pa3;
#define PK4(Pv, B_, OUT) do { unsigned a0 = cvtpk(Pv[B_+0], Pv[B_+1]), a1 = cvtpk(Pv[B_+2], Pv[B_+3]); unsigned b0 = cvtpk(Pv[B_+4], Pv[B_+5]), b1 = cvtpk(Pv[B_+6], Pv[B_+7]); \
        auto r0 = __builtin_amdgcn_permlane32_swap(a0, b0, false, false); auto r1 = __builtin_amdgcn_permlane32_swap(a1, b1, false, false); \
        v4u w = {r0[0], r1[0], r0[1], r1[1]}; OUT = __builtin_bit_cast(bf16x8, w); } while (0)
    PK4(p0, 0, pa0); PK4(p0, 8, pa1); PK4(p1, 0, pa2); PK4(p1, 8, pa3);
#undef PK4
    if (__any(alpha < 1.f)) { if (hi == 0) al_l[r32] = alpha; asm volatile("s_waitcnt lgkmcnt(0)" ::: "memory");
#pragma unroll
        for (int d_ = 0; d_ < 4; ++d_)
#pragma unroll
            for (int r = 0; r < 16; ++r) o[d_][r] *= al_l[crow(r, hi)]; }
    SBAR();
    pv_tile<BUF>(o, vb0, pa0, pa1, pa2, pa3);
}
__device__ __forceinline__ void fox_attn_unit(const Params& P, char* lds, int b, int h, int qb) {
    const int tid = opaque_tid(), wid = __builtin_amdgcn_readfirstlane(tid >> 6), lane = tid & 63, r32 = lane & 31, hi = lane >> 5;
    unsigned char* ws = P.ws; const bf16* PROJ = (const bf16*)(ws + WS_PROJ); const float* CF = (const float*)(ws + WS_CF) + (size_t)(b * 16 + h) * SEQ; bf16* OB = (bf16*)(ws + WS_OB);
    char* V_lds = lds; char* K_lds = lds + 2 * SHM_V;
    float* ckl = (float*)(lds + 2 * SHM_V + 2 * SHM_K);
    float* al_l = (float*)(lds + 2 * SHM_V + 2 * SHM_K + 16384) + wid * 64;
    const int q0 = qb * 256, qlo = q0 + wid * 32, qpos = qlo + r32;
    const bf16* Qp = PROJ + (size_t)(b * SEQ + qpos) * LD1 + h * 128 + hi * 8;
    const bf16* Kh = PROJ + (size_t)(b * SEQ) * LD1 + 2048 + h * 128; const bf16* Vh = Kh + 2048;
    bf16x8* qr = (bf16x8*)(lds + 83968 + wid * 8192) + lane;
    float* kgl = (float*)(lds + 149504);
    if (tid < 32) ((f32x4*)kgl)[tid] = ((const f32x4*)(ws + WS_KGAIN))[tid];
    {
      v4u qv[8]; float ssq = 0.f;
#pragma unroll
      for (int d0 = 0; d0 < 8; ++d0) { qv[d0] = *(const v4u*)(Qp + d0 * 16);
#pragma unroll
          for (int e = 0; e < 4; ++e) { const float a = __builtin_bit_cast(float, qv[d0][e] << 16), c = __builtin_bit_cast(float, qv[d0][e] & 0xffff0000u); ssq += a * a + c * c; } }
      ssq += __shfl_xor(ssq, 32);
      const float rq = (0.08838834764831845f * LOG2E) / sqrtf(ssq * (1.0f / 128.0f) + 1e-6f); const float* qgn = (const float*)(ws + WS_QGAIN) + hi * 8;
#pragma unroll
      for (int d0 = 0; d0 < 8; ++d0) { const f32x4 g0 = *(const f32x4*)(qgn + d0 * 16), g1 = *(const f32x4*)(qgn + d0 * 16 + 4); v4u w;
#pragma unroll
          for (int e = 0; e < 4; ++e) { const float a = __builtin_bit_cast(float, qv[d0][e] << 16), c = __builtin_bit_cast(float, qv[d0][e] & 0xffff0000u); const float ga = e < 2 ? g0[2 * e] : g1[2 * e - 4], gc = e < 2 ? g0[2 * e + 1] : g1[2 * e - 3];
              w[e] = cvtpk(a * rq * ga, c * rq * gc); }
          qr[d0 * 64] = __builtin_bit_cast(bf16x8, w); } }
    const float cq = CF[qpos];
    const int sr = tid >> 4, sc = (tid & 15) * 8, vst0 = v_st(sr, sc), vst1 = v_st(32 + sr, sc), kws = KSWZ(sr, sc * 2);
    const int vb0 = (int)(uintptr_t)V_lds + v_rd_base(lane);
    const int NT = 4 * (qb + 1);
    bf16x8 st_k0, st_k1, st_v0, st_v1;
    for (int i = tid; i < (q0 + 256) / 4; i += NTHREADS) ((f32x4*)ckl)[i] = ((const f32x4*)CF)[i];
#define SLOAD(t) do { const size_t r0_ = (size_t)((t) * 64 + sr) * LD1 + sc; st_k0 = *(const bf16x8*)(Kh + r0_); st_k1 = *(const bf16x8*)(Kh + r0_ + (size_t)32 * LD1); \
        st_v0 = *(const bf16x8*)(Vh + r0_); st_v1 = *(const bf16x8*)(Vh + r0_ + (size_t)32 * LD1); } while (0)
#define SWRITE(bf) do { *(bf16x8*)(K_lds + (bf) * SHM_K + kws) = knorm8(st_k0, kgl + sc); *(bf16x8*)(K_lds + (bf) * SHM_K + kws + 32 * 256) = knorm8(st_k1, kgl + sc); \
        *(bf16x8*)(V_lds + (bf) * SHM_V + vst0) = st_v0; *(bf16x8*)(V_lds + (bf) * SHM_V + vst1) = st_v1; } while (0)
    float m_reg = -1e30f, l_reg = 0.f; f32x16 o[4] = {};
    __syncthreads();
    int j_lo; { const float thr = *(const float*)(ws + WS_THR), cq0 = ckl[q0];
        const bool skip = lane < 4 * qb && ckl[64 * lane + 63] - cq0 > thr; const unsigned long long bm = __ballot(!skip); j_lo = (int)__builtin_ctzll(bm) & ~1; }
    SLOAD(NT - 1); SWRITE(0);
    __syncthreads();
    for (int t = NT - 1; t > j_lo; t -= 2) {
        SLOAD(t - 1);
        { const int kb0 = t * 64; fox_tile<0>(o, m_reg, l_reg, lds, ckl, al_l, vb0, qr, cq, qpos, kb0, kb0 + 63 > qlo, r32, hi); }
        SWRITE(1);
        __syncthreads();
        if (t - 2 > j_lo) SLOAD(t - 2);
        { const int kb0 = (t - 1) * 64; fox_tile<1>(o, m_reg, l_reg, lds, ckl, al_l, vb0, qr, cq, qpos, kb0, kb0 + 63 > qlo, r32, hi); }
        if (t - 2 > j_lo) SWRITE(0);
        __syncthreads();
    }
#undef SLOAD
#undef SWRITE
    if (hi == 0) al_l[r32] = l_reg; asm volatile("s_waitcnt lgkmcnt(0)" ::: "memory");
    bf16* stg = (bf16*)(lds + wid * 8192);
#pragma unroll
    for (int r = 0; r < 16; ++r) { const int row = crow(r, hi); const float rl = 1.0f / al_l[row];
#pragma unroll
        for (int d_ = 0; d_ < 4; ++d_) stg[row * 128 + d_ * 32 + r32] = (bf16)f2bf(o[d_][r] * rl); }
    asm volatile("s_waitcnt lgkmcnt(0)" ::: "memory");
    { const int ch = lane & 15; const bf16* ogp = PROJ + (size_t)(b * SEQ + qlo) * LD1 + 6144 + h * 128 + ch * 8; bf16* op = OB + (size_t)(b * SEQ + qlo) * DM + h * 128 + ch * 8;
#pragma unroll 2
      for (int i = 0; i < 8; ++i) { const int row = i * 4 + (lane >> 4); const v4u ov = *(const v4u*)(stg + row * 128 + ch * 8); const v4u gv = *(const v4u*)(ogp + (size_t)row * LD1); v4u w;
#pragma unroll
          for (int e = 0; e < 4; ++e) { const float o0 = __builtin_bit_cast(float, ov[e] << 16), o1 = __builtin_bit_cast(float, ov[e] & 0xffff0000u), g0 = __builtin_bit_cast(float, gv[e] << 16), g1 = __builtin_bit_cast(float, gv[e] & 0xffff0000u);
              w[e] = pk2(o0 / (1.0f + __expf(-g0)), o1 / (1.0f + __expf(-g1))); }
          *(v4u*)(op + (size_t)row * DM) = w; } }
    __syncthreads();
}
#define RLX_AGENT __ATOMIC_RELAXED, __HIP_MEMORY_SCOPE_AGENT
#define XB_TMO      128
#define XB_XCNT(j)  (256  + 64 * (j))
#define XB_XSUB(j)  (1280 + 64 * (j))
#define XB_XGEN(j)  (2304 + 64 * (j))
#define XB_TOP      3328
#define XB_TOPGEN   3392
#define XCD_BAR_WORDS 3456
#define XB_SPIN_CAP (1u << 18)

__device__ __forceinline__ unsigned xb_ld(unsigned* p)              { return __hip_atomic_load(p, __ATOMIC_RELAXED, __HIP_MEMORY_SCOPE_AGENT); }
__device__ __forceinline__ unsigned xb_add(unsigned* p, unsigned v) { return __hip_atomic_fetch_add(p, v, __ATOMIC_RELAXED, __HIP_MEMORY_SCOPE_AGENT); }
__device__ __forceinline__ unsigned xb_xcc_id() { return (unsigned)__builtin_amdgcn_s_getreg((3 << 11) | 20) & 0xFu; }
#define XB_SPIN(cond, bar) do { unsigned _sp = 0; while (cond) { __builtin_amdgcn_s_sleep(1); \
    if ((++_sp & 255u) == 0u) { if (xb_ld(&(bar)[XB_TMO])) break; if (_sp > XB_SPIN_CAP) { atomicAdd(&(bar)[XB_TMO], 1u); break; } } } } while (0)

struct XcdBarrier {
    unsigned* bar; unsigned x;
    volatile LAS unsigned* st;
};

__device__ __forceinline__ XcdBarrier xcd_barrier_post(unsigned* bar, volatile LAS unsigned* st) {
    XcdBarrier b; b.bar = bar; b.x = xb_xcc_id(); b.st = st;
    if (threadIdx.x == 0) (void)xb_add(&bar[XB_XCNT(b.x)], 1u);
    return b;
}
__device__ __forceinline__ void xcd_barrier_complete(unsigned* bar, unsigned x, unsigned& nloc, unsigned& nx) {
    const unsigned G = gridDim.x * gridDim.y * gridDim.z;
    unsigned sum, cnt, mine, sp = 0u;
    for (;;) {
        sum = 0u; cnt = 0u; mine = 0u;
#pragma unroll
        for (unsigned j = 0; j < 16; ++j) { const unsigned c = xb_ld(&bar[XB_XCNT(j)]); sum += c; cnt += (c > 0u) ? 1u : 0u; mine = (j == x) ? c : mine; }
        if (sum == G) break;
        __builtin_amdgcn_s_sleep(1);
        if ((++sp & 255u) == 0u) { if (xb_ld(&bar[XB_TMO])) break; if (sp > XB_SPIN_CAP) { atomicAdd(&bar[XB_TMO], 1u); break; } }
    }
    nloc = mine > 0u ? mine : 1u; nx = cnt > 0u ? cnt : 1u;
}

__device__ __forceinline__ void xcd_barrier(const XcdBarrier& b) {
    asm volatile("s_waitcnt vmcnt(0)" ::: "memory");
    __syncthreads();
    if (threadIdx.x == 0) {
        unsigned* bar = b.bar;
        __builtin_amdgcn_s_waitcnt(0);
        unsigned nloc = b.st[0], nx = b.st[1];
        if (nloc == 0u) { xcd_barrier_complete(bar, b.x, nloc, nx); b.st[0] = nloc; b.st[1] = nx; }
        const unsigned old = xb_add(&bar[XB_XSUB(b.x)], 1u);
        const unsigned gen = old / nloc;
        if (old + 1u == (gen + 1u) * nloc) {
            __builtin_amdgcn_fence(__ATOMIC_RELEASE, "agent");
            asm volatile("s_waitcnt vmcnt(0)" ::: "memory");
            const unsigned og = xb_add(&bar[XB_TOP], 1u);
            const unsigned tg = og / nx;
            if (og + 1u == (tg + 1u) * nx) xb_add(&bar[XB_TOPGEN], 1u);
            else XB_SPIN(xb_ld(&bar[XB_TOPGEN]) == tg, bar);
            __builtin_amdgcn_fence(__ATOMIC_ACQUIRE, "agent");
            xb_add(&bar[XB_XGEN(b.x)], 1u);
            asm volatile("s_waitcnt vmcnt(0)" ::: "memory");
        } else {
            XB_SPIN(xb_ld(&bar[XB_XGEN(b.x)]) == gen, bar);
            __builtin_amdgcn_fence(__ATOMIC_ACQUIRE, "agent");
            asm volatile("s_waitcnt vmcnt(0)" ::: "memory");
        }
    }
    __syncthreads();
}
constexpr int N_PHASES = 14;
#ifndef MK_MULTI
#define MK_MULTI 0
#endif
__global__ void __launch_bounds__(NTHREADS, 2) hybrid_fwd(Params P) {
    extern __shared__ __attribute__((aligned(16))) unsigned char lds_raw[];
    LAS unsigned char* lds = (LAS unsigned char*)lds_raw;
    cg::grid_group grid = cg::this_grid();
    unsigned char* ws = P.ws;
    volatile LAS unsigned* bst = (volatile LAS unsigned*)(lds + LDS_BYTES - 64);
    if (threadIdx.x == 0) { bst[0] = 0u; bst[1] = 0u; }
    __syncthreads();
    XcdBarrier xbar = xcd_barrier_post((unsigned*)(ws + WS_BAR), bst);
    const int vcu = (gridDim.x % 8 == 0) ? (int)((blockIdx.x % 8) * (gridDim.x / 8) + blockIdx.x / 8) : (int)blockIdx.x;
#if MK_MULTI
    const int lo = P.ph_lo, hi = P.ph_hi;
#else
    constexpr int lo = 0, hi = 14;
#endif
    bf16* XB = (bf16*)(ws + WS_XB); bf16* OB = (bf16*)(ws + WS_OB); bf16* PROJ = (bf16*)(ws + WS_PROJ); float* SSQ = (float*)(ws + WS_SSQ); float* GLR = (float*)(ws + WS_GLR);
#ifndef PHM
#define PHM 0x3fff
#endif
#define IN(k) ((((PHM) >> (k)) & 1) && lo <= (k) && (k) < hi)
#ifndef DUP
#define DUP -1
#endif
#define SEAM(k) do { if (IN(k) && IN((k) + 1)) xcd_barrier(xbar); } while (0)
    if (P.ph_hi < 0) grid.sync();
    for (int rep_ = 0; rep_ < (DUP == 0 ? 2 : 1); ++rep_)
    if (IN(0)) { p0_prologue(P, lds, 0, blockIdx.x, gridDim.x); } SEAM(0);
    if (IN(1)) {
        pg8::Gemm g{XB, (const bf16*)(ws + WS_WGI), M, 6144, DM}; pg8::StaticOrder S; S.init(M, 6144, gridDim.x, blockIdx.x);
        PG8_LAS float* rst = (PG8_LAS float*)(lds + 131072); pg8::fill_rstd_table(rst, SSQ, S);
        pg8::EpiScaleBf16 E{PROJ, LD0, rst};
        pg8::gemm_phase<pg8::EpiScaleBf16, pg8::StaticOrder, true, true>(lds, g, S, E);
        thin_gemm(XB, (const bf16*)(ws + WS_W1T), SSQ, GLR, lds);
    } SEAM(1);
    for (int rep_ = 0; rep_ < (DUP == 2 ? 2 : 1); ++rep_)
    if (IN(2)) { for (int u = blockIdx.x; u < 512; u += gridDim.x) gla_prep_unit(P, lds, u); } SEAM(2);
    for (int rep_ = 0; rep_ < (DUP == 3 ? 2 : 1); ++rep_)
    if (IN(3)) { for (int u = blockIdx.x; u < 256; u += gridDim.x) gla_scan_unit(P, lds, u); } SEAM(3);
    for (int rep_ = 0; rep_ < (DUP == 4 ? 2 : 1); ++rep_)
    if (IN(4)) { for (int u = blockIdx.x; u < 512; u += gridDim.x) gla_out_unit(P, lds, u); } SEAM(4);
#ifdef SYNCX
    for (int rep_ = 0; rep_ < SYNCX; ++rep_) xcd_barrier(xbar);
#endif
    for (int rep_ = 0; rep_ < (DUP == 5 ? 2 : 1); ++rep_)
    if (IN(5)) {
        pg8::Gemm g{OB, (const bf16*)(ws + WS_WGO), M, DM, DM}; pg8::StaticOrder S; S.init(M, DM, gridDim.x, blockIdx.x);
        pg8::EpiResid<0> E{P.x, P.out, XB, SSQ};
        pg8::gemm_phase<pg8::EpiResid<0>, pg8::StaticOrder, true, true>(lds, g, S, E);
    } SEAM(5);
    for (int rep_ = 0; rep_ < (DUP == 6 ? 2 : 1); ++rep_)
    if (IN(6)) {
        const int ngemm = (gridDim.x == 256 && DUP != 6) ? 235 : (int)gridDim.x;
        if ((int)blockIdx.x < ngemm) {
        pg8::Gemm g{XB, (const bf16*)(ws + WS_WGU0), M, 2 * DFF, DM}; pg8::StaticOrder S; S.init(M, 2 * DFF, ngemm, blockIdx.x);
        PG8_LAS float* rst = (PG8_LAS float*)(lds + 131072); pg8::fill_rstd_table(rst, SSQ, S);
        pg8::EpiSwiGLU E{PROJ, DFF, rst};
        pg8::gemm_phase<pg8::EpiSwiGLU, pg8::StaticOrder, true, true>(lds, g, S, E);
        if (ngemm == (int)gridDim.x && rep_ == 0) p0_prologue(P, lds, 1, blockIdx.x, gridDim.x);
        } else p0_prologue(P, lds, 1, blockIdx.x - ngemm, gridDim.x - ngemm);
    } SEAM(6);
    if (IN(7)) {
        pg8::Gemm g{PROJ, (const bf16*)(ws + WS_WD0), M, DM, DFF}; pg8::StaticOrder S; S.init(M, DM, gridDim.x, blockIdx.x);
        pg8::EpiResid<1> E{nullptr, P.out, XB, SSQ};
        pg8::gemm_phase<pg8::EpiResid<1>, pg8::StaticOrder, true, true>(lds, g, S, E);
    } SEAM(7);
    if (IN(8)) {
        pg8::Gemm g{XB, (const bf16*)(ws + WS_WFI), M, 8192, DM}; pg8::StaticOrder S; S.init(M, 8192, gridDim.x, blockIdx.x);
        PG8_LAS float* rst = (PG8_LAS float*)(lds + 131072); pg8::fill_rstd_table(rst, SSQ, S);
        pg8::EpiScaleBf16 E{PROJ, LD1, rst};
        pg8::gemm_phase<pg8::EpiScaleBf16, pg8::StaticOrder, true, true>(lds, g, S, E);
        thin_gemm(XB, (const bf16*)(ws + WS_WFT), SSQ, GLR, lds);
    } SEAM(8);
    if (IN(9)) { fox_prep(P, lds); } SEAM(9);
    for (int rep_ = 0; rep_ < (DUP == 10 ? 2 : 1); ++rep_)
    if (IN(10)) {
        for (int pr = vcu; pr < 256; pr += gridDim.x) { const int bh = pr >> 3, s = pr & 7;
            fox_attn_unit(P, (char*)lds_raw, bh >> 4, bh & 15, 15 - s); fox_attn_unit(P, (char*)lds_raw, bh >> 4, bh & 15, s); }
    } SEAM(10);
    if (IN(11)) {
        pg8::Gemm g{OB, (const bf16*)(ws + WS_WFO), M, DM, DM}; pg8::StaticOrder S; S.init(M, DM, gridDim.x, blockIdx.x);
        pg8::EpiResid<1> E{nullptr, P.out, XB, SSQ};
        pg8::gemm_phase<pg8::EpiResid<1>, pg8::StaticOrder, true, true>(lds, g, S, E);
    } SEAM(11);
    if (IN(12)) {
        const int ngemm = gridDim.x == 256 ? 235 : (int)gridDim.x;
        if ((int)blockIdx.x < ngemm) {
        pg8::Gemm g{XB, (const bf16*)(ws + WS_WGU1), M, 2 * DFF, DM}; pg8::StaticOrder S; S.init(M, 2 * DFF, ngemm, blockIdx.x);
        PG8_LAS float* rst = (PG8_LAS float*)(lds + 131072); pg8::fill_rstd_table(rst, SSQ, S);
        pg8::EpiSwiGLU E{PROJ, DFF, rst};
        pg8::gemm_phase<pg8::EpiSwiGLU, pg8::StaticOrder, true, true>(lds, g, S, E);
        if (ngemm == (int)gridDim.x) p0_prologue(P, lds, 2, blockIdx.x, gridDim.x);
        } else p0_prologue(P, lds, 2, blockIdx.x - ngemm, gridDim.x - ngemm);
    } SEAM(12);
    if (IN(13)) {
        pg8::Gemm g{PROJ, (const bf16*)(ws + WS_WD1), M, DM, DFF}; pg8::StaticOrder S; S.init(M, DM, gridDim.x, blockIdx.x);
        pg8::EpiResid<2> E{nullptr, P.out, XB, SSQ};
        pg8::gemm_phase<pg8::EpiResid<2>, pg8::StaticOrder, true, true>(lds, g, S, E);
    }
#undef IN
#undef SEAM
}

extern "C" void kernel_launch(void* const* d_in, const int* in_sizes, int n_in, void* d_out, int out_size, void* d_ws, size_t ws_size, hipStream_t stream) {
    static int grid = 0;
    if (grid == 0) {
        if (n_in != 16 || in_sizes[0] != M * DM || out_size != M * DM || ws_size < WS_END) { fprintf(stderr, "kernel_launch: unexpected shapes/workspace (n_in %d, ws %zu, need %zu)\n", n_in, ws_size, (size_t)WS_END); grid = -1; return; }
        int dev = 0, cus = 0, per_cu = 0;
        hipGetDevice(&dev); hipDeviceGetAttribute(&cus, hipDeviceAttributeMultiprocessorCount, dev);
        if (hipFuncSetAttribute((const void*)hybrid_fwd, hipFuncAttributeMaxDynamicSharedMemorySize, LDS_BYTES) != hipSuccess) { fprintf(stderr, "kernel_launch: hipFuncSetAttribute failed\n"); grid = -1; return; }
        if (hipOccupancyMaxActiveBlocksPerMultiprocessor(&per_cu, (const void*)hybrid_fwd, NTHREADS, LDS_BYTES) != hipSuccess || per_cu < 1) { fprintf(stderr, "kernel_launch: occupancy query gives %d\n", per_cu); per_cu = 1; (void)hipGetLastError(); }
        grid = cus * per_cu;
        fprintf(stderr, "kernel_launch: grid %d (%d CUs x %d)\n", grid, cus, per_cu);
    }
    if (grid < 0) return;
    if (hipMemsetAsync((char*)d_ws + WS_BAR, 0, 16384, stream) != hipSuccess) { fprintf(stderr, "kernel_launch: memset failed\n"); return; }
    Params p{};
    const float* const* in = (const float* const*)d_in;
    p.x = in[0]; p.norm_mix = in[1]; p.norm_ffn = in[2]; p.gla_w_in = in[3]; p.gla_w_g2 = in[4]; p.gla_b_g2 = in[5]; p.gla_o_gain = in[6]; p.gla_w_o = in[7];
    p.fox_w_in = in[8]; p.fox_b_f = in[9]; p.fox_q_gain = in[10]; p.fox_k_gain = in[11]; p.fox_w_o = in[12]; p.ffn_w_gate = in[13]; p.ffn_w_up = in[14]; p.ffn_w_down = in[15];
    p.out = (float*)d_out; p.ws = (unsigned char*)d_ws;
#if MK_MULTI
    for (int ph = 0; ph < N_PHASES; ++ph) { p.ph_lo = ph; p.ph_hi = ph + 1; hipLaunchKernelGGL(hybrid_fwd, dim3(grid), dim3(NTHREADS), LDS_BYTES, stream, p); }
#else
    p.ph_lo = 0; p.ph_hi = N_PHASES;
    void* args[] = {&p};
    hipError_t e = hipLaunchCooperativeKernel((const void*)hybrid_fwd, dim3(grid), dim3(NTHREADS), args, LDS_BYTES, stream);
    if (e != hipSuccess) fprintf(stderr, "cooperative launch failed: %s (grid %d)\n", hipGetErrorString(e), grid);
#endif
}
```

```cpp
#include <hip/hip_runtime.h>
#include <hip/hip_cooperative_groups.h>
#include <cstdio>
#include <cstdint>
namespace cg = cooperative_groups;
__device__ __forceinline__ int opaque_tid() { int t = threadIdx.x; asm volatile("" : "+v"(t)); return t; }
typedef float f32x2_t __attribute__((ext_vector_type(2))); typedef __bf16 bf16x2_t __attribute__((ext_vector_type(2)));
__device__ __forceinline__ unsigned cvtpk(float lo, float hi) { f32x2_t v = {lo, hi}; bf16x2_t b = __builtin_convertvector(v, bf16x2_t); return __builtin_bit_cast(unsigned, b); }
namespace pg8 {
#define PG8_LAS __attribute__((address_space(3)))
typedef unsigned short bf16_t;
typedef short bf16x8 __attribute__((ext_vector_type(8)));
typedef float f32x4 __attribute__((ext_vector_type(4)));
typedef unsigned u32x4 __attribute__((ext_vector_type(4)));
constexpr int BM = 256, BK = 64, HALF = 128, HTB = HALF * BK * 2  , STAGE_BYTES = 8 * HTB, NXCD = 8, WGM = 8;

__host__ __device__ __forceinline__ int lds_byte(int r, int c) { const int st = (r >> 4) * 2 + (c >> 5), rr = r & 15, cc = c & 31, ob = rr * 64 + cc * 2; return st * 1024 + (ob ^ (((ob >> 9) & 1) << 5)); }
__host__ __device__ __forceinline__ void stage_rc(int b, int& R, int& C) { const int st = b / 1024, sb = b % 1024, swz = sb ^ (((sb >> 9) & 1) << 5); R = (st >> 1) * 16 + swz / 64; C = (st & 1) * 32 + (swz % 64) / 2; }
__host__ __device__ __forceinline__ int perm32(int rho) { const int n = rho >> 4, i = rho & 15; return 8 * (i >> 2) + 4 * n + (i & 3); }

struct Unit { int pm, pn; };
struct Gemm { const bf16_t* A; const bf16_t* Bt; int M, N, K; };

struct StaticOrder {
    int nM, nN, nwg, G, c;
    __host__ __device__ void init(int M, int N, int G_, int c_) { nM = M / BM; nN = N / BM; nwg = nM * nN; G = G_; c = c_; }
    __host__ __device__ bool next(int i, Unit& u) const {
        const long L = (long)i * G + c; if (L >= nwg) return false;
        int wgid = (int)L; { const int q = nwg / NXCD, r = nwg % NXCD, xcd = wgid % NXCD, off = wgid / NXCD; wgid = (xcd < r ? xcd * (q + 1) : r * (q + 1) + (xcd - r) * q) + off; }
        const int nig = WGM * nN, gid = wgid / nig, fm = gid * WGM, gsz = (nM - fm) < WGM ? (nM - fm) : WGM;
        u.pm = fm + ((wgid % nig) % gsz); u.pn = (wgid % nig) / gsz; return true;
    }
    __device__ __forceinline__ void a_ready(const Unit&) const {}
    __device__ __forceinline__ void done(const Unit&) const {}
};

typedef unsigned u32x2 __attribute__((ext_vector_type(2)));
__device__ __forceinline__ unsigned cvt_pk_bf16(float lo, float hi) { return ::cvtpk(lo, hi); }
constexpr float RMS_EPS = 1e-6f;
__device__ __forceinline__ void row_rstd(const float* ssq, int row0, int fq, float (&rs)[2][4]) {
#pragma unroll
    for (int ai = 0; ai < 2; ++ai)
#pragma unroll
        for (int m = 0; m < 4; ++m) { const f32x4* p = (const f32x4*)(ssq + (size_t)(row0 + ai * HALF + m * 16) * 32 + fq * 8); const f32x4 a = p[0], b = p[1];
            float s = ((a[0] + a[1]) + (a[2] + a[3])) + ((b[0] + b[1]) + (b[2] + b[3])); s += __shfl_xor(s, 16); s += __shfl_xor(s, 32);
            rs[ai][m] = 1.0f / sqrtf(s * (1.0f / 2048.0f) + RMS_EPS); }
}
__device__ __forceinline__ void rstd_from_table(const PG8_LAS float* t, float (&rs)[2][4]) {
#pragma unroll
    for (int ai = 0; ai < 2; ++ai)
#pragma unroll
        for (int m = 0; m < 4; ++m) rs[ai][m] = t[ai * HALF + m * 16];
}
template <class Sched> __device__ __forceinline__ void fill_rstd_table(PG8_LAS float* tab, const float* ssq, const Sched& S) {
    const int tid = threadIdx.x, r = tid >> 1, hf = tid & 1; Unit u;
    for (int i = 0; S.next(i, u); ++i) { const f32x4* p = (const f32x4*)(ssq + (size_t)(u.pm * BM + r) * 32 + hf * 16); float s = 0.f;
#pragma unroll
        for (int j = 0; j < 4; ++j) { const f32x4 a = p[j]; s += (a[0] + a[1]) + (a[2] + a[3]); }
        s += __shfl_xor(s, 1);
        if (hf == 0) tab[i * 256 + r] = 1.0f / sqrtf(s * (1.0f / 2048.0f) + RMS_EPS); }
    __syncthreads();
}
struct EpiScaleBf16 {
    static constexpr bool PERM = true, AFTER_DRAIN = false;
    bf16_t* O; int ldc; const PG8_LAS float* rst;
    __device__ __forceinline__ void operator()(const f32x4 (&acc)[2][2][4][2], const Unit& u, int wr, int wc, int fr, int fq, int ui) const {
        const int row0 = u.pm * BM + wr * 64 + fr, col0 = u.pn * BM + wc * 32 + 8 * fq;
        float rs[2][4]; rstd_from_table(rst + ui * 256 + wr * 64 + fr, rs);
#pragma unroll
        for (int ai = 0; ai < 2; ++ai)
#pragma unroll
            for (int m = 0; m < 4; ++m) { bf16_t* rowp = O + (size_t)(row0 + ai * HALF + m * 16) * ldc + col0; const float r = rs[ai][m];
#pragma unroll
                for (int bj = 0; bj < 2; ++bj) { const f32x4 v0 = acc[ai][bj][m][0] * r, v1 = acc[ai][bj][m][1] * r;
                    u32x4 w; w.x = cvt_pk_bf16(v0[0], v0[1]); w.y = cvt_pk_bf16(v0[2], v0[3]); w.z = cvt_pk_bf16(v1[0], v1[1]); w.w = cvt_pk_bf16(v1[2], v1[3]);
                    *(u32x4*)(rowp + bj * HALF) = w; } }
    }
};
__device__ __forceinline__ float silu_f(float g) { return g * __builtin_amdgcn_rcpf(1.0f + __expf(-g)); }
struct EpiSwiGLU {
    static constexpr bool PERM = true, AFTER_DRAIN = false;
    bf16_t* O; int ldc; const PG8_LAS float* rst;
    __device__ __forceinline__ void operator()(const f32x4 (&acc)[2][2][4][2], const Unit& u, int wr, int wc, int fr, int fq, int ui) const {
        const int row0 = u.pm * BM + wr * 64 + fr, col0 = u.pn * HALF + wc * 32 + 8 * fq;
        float rs[2][4]; rstd_from_table(rst + ui * 256 + wr * 64 + fr, rs);
#pragma unroll
        for (int ai = 0; ai < 2; ++ai)
#pragma unroll
            for (int m = 0; m < 4; ++m) { bf16_t* rowp = O + (size_t)(row0 + ai * HALF + m * 16) * ldc + col0; const float r = rs[ai][m];
                float o[8];
#pragma unroll
                for (int n = 0; n < 2; ++n)
#pragma unroll
                    for (int e = 0; e < 4; ++e) { const float g = acc[ai][0][m][n][e] * r, up = acc[ai][1][m][n][e] * r; o[n * 4 + e] = silu_f(g) * up; }
                u32x4 w; w.x = cvt_pk_bf16(o[0], o[1]); w.y = cvt_pk_bf16(o[2], o[3]); w.z = cvt_pk_bf16(o[4], o[5]); w.w = cvt_pk_bf16(o[6], o[7]);
                *(u32x4*)rowp = w; }
    }
};
template <int MODE> struct EpiResid {
    static constexpr bool PERM = false, AFTER_DRAIN = false;
    const float* base; float* out; bf16_t* xb; float* ssq;
    __device__ __forceinline__ void operator()(const f32x4 (&acc)[2][2][4][2], const Unit& u, int wr, int wc, int fr, int fq, int) const {
        const int row0 = u.pm * BM + wr * 64 + fr, col0 = u.pn * BM + wc * 32 + 4 * fq;
#pragma unroll
        for (int ai = 0; ai < 2; ++ai)
#pragma unroll
            for (int m = 0; m < 4; ++m) { const int row = row0 + ai * HALF + m * 16; const size_t off = (size_t)row * 2048 + col0; float s = 0.f;
#pragma unroll
                for (int bj = 0; bj < 2; ++bj)
#pragma unroll
                    for (int n = 0; n < 2; ++n) { const size_t o2 = off + bj * HALF + n * 16; f32x4 bs;
                        if (MODE == 0) bs = __builtin_nontemporal_load((const f32x4*)(base + o2));
                        else { const u32x2 b2 = *(const u32x2*)(xb + o2); bs[0] = __builtin_bit_cast(float, b2.x << 16); bs[1] = __builtin_bit_cast(float, b2.x & 0xffff0000u); bs[2] = __builtin_bit_cast(float, b2.y << 16); bs[3] = __builtin_bit_cast(float, b2.y & 0xffff0000u); }
                        const f32x4 o = bs + acc[ai][bj][m][n];
                        if (MODE == 2) __builtin_nontemporal_store(o, (f32x4*)(out + o2));
                        else { s += (o[0] * o[0] + o[1] * o[1]) + (o[2] * o[2] + o[3] * o[3]); u32x2 w; w.x = cvt_pk_bf16(o[0], o[1]); w.y = cvt_pk_bf16(o[2], o[3]); *(u32x2*)(xb + o2) = w; } }
                if (MODE != 2) { s += __shfl_xor(s, 16); s += __shfl_xor(s, 32); if (fq == 0) ssq[(size_t)row * 32 + u.pn * 4 + wc] = s; } }
    }
};
template <class Epi, class Sched, bool ALIGN_EPI = false, bool SP2 = false>
__device__ __forceinline__ void gemm_phase(PG8_LAS unsigned char* lds, const Gemm g, const Sched& S, const Epi& E) {
    const int tid = opaque_tid(), wid = __builtin_amdgcn_readfirstlane(tid >> 6), lane = tid & 63, wr = wid >> 2, wc = wid & 3, fr = lane & 15, fq = lane >> 4;
    const int K = g.K, nt = K / BK;
    unsigned voffA[2], voffB[2];
#pragma unroll
    for (int i = 0; i < 2; ++i) { int R, C; stage_rc(tid * 16 + i * 8192, R, C); const int Rb = Epi::PERM ? ((R & ~31) + perm32(R & 31)) : R;
        voffA[i] = (unsigned)(R * K + C) * 2u; voffB[i] = (unsigned)(Rb * K + C) * 2u; }
    const size_t kstep = (size_t)(BK * 2);
    const size_t hstep = (size_t)HALF * K * 2;
    const size_t tstep = 2 * hstep;
    const unsigned ldsw = (unsigned)wid * 1024u;
    const int aoff = lds_byte(wr * 64 + fr, fq * 8), boff = lds_byte(wc * 32 + fr, fq * 8);
#define PG8_SA(b, h) (((b) * 2 + (h)) * HTB)
#define PG8_SB(b, h) ((4 + (b) * 2 + (h)) * HTB)
#define PG8_STAGE(bufoff, gbase, voff) do { _Pragma("unroll") for (int _i = 0; _i < 2; ++_i) \
        __builtin_amdgcn_global_load_lds((const unsigned*)((const char*)(gbase) + (voff)[_i]), (PG8_LAS unsigned*)(lds + (bufoff) + ldsw + _i * 8192), 16, 0, 0); } while (0)
#define PG8_LDA(dst, b, h) do { _Pragma("unroll") for (int m = 0; m < 4; ++m) _Pragma("unroll") for (int k = 0; k < 2; ++k) dst[m][k] = *(const PG8_LAS bf16x8*)(lds + PG8_SA(b, h) + aoff + m * 2048 + k * 1024); } while (0)
#define PG8_LDB(dst, b, h) do { _Pragma("unroll") for (int n = 0; n < 2; ++n) _Pragma("unroll") for (int k = 0; k < 2; ++k) dst[n][k] = *(const PG8_LAS bf16x8*)(lds + PG8_SB(b, h) + boff + n * 2048 + k * 1024); } while (0)
#define PG8_MMA(ai, bj, At, Bt) do { __builtin_amdgcn_s_setprio(1); _Pragma("unroll") for (int m = 0; m < 4; ++m) _Pragma("unroll") for (int n = 0; n < 2; ++n) _Pragma("unroll") for (int k = 0; k < 2; ++k) \
        acc[ai][bj][m][n] = __builtin_amdgcn_mfma_f32_16x16x32_bf16(Bt[n][k], At[m][k], acc[ai][bj][m][n], 0, 0, 0); __builtin_amdgcn_s_setprio(0); } while (0)
#define PG8_WAIT_V(n) asm volatile("s_waitcnt vmcnt(" #n ")" ::: "memory")
#define PG8_WAIT_L(n) asm volatile("s_waitcnt lgkmcnt(" #n ")" ::: "memory")
#define PG8_BAR __builtin_amdgcn_s_barrier()
#define PG8_SCHED __builtin_amdgcn_sched_barrier(0)
    Unit cur, nxt; int ui = 0;
    if (!S.next(0, cur)) return;
    f32x4 acc[2][2][4][2];
#pragma unroll
    for (int a = 0; a < 2; ++a)
#pragma unroll
        for (int b = 0; b < 2; ++b)
#pragma unroll
            for (int m = 0; m < 4; ++m)
#pragma unroll
                for (int n = 0; n < 2; ++n) acc[a][b][m][n] = (f32x4){0.f, 0.f, 0.f, 0.f};
    bf16x8 At[4][2], B0[2][2], B1[2][2];
    const char* cA = (const char*)g.A + (size_t)cur.pm * tstep; const char* cB = (const char*)g.Bt + (size_t)cur.pn * tstep;
    S.a_ready(cur);
    if constexpr (SP2) {
        PG8_STAGE(PG8_SB(0, 0), cB, voffB); PG8_STAGE(PG8_SB(0, 1), cB + hstep, voffB); PG8_STAGE(PG8_SA(0, 0), cA, voffA); PG8_STAGE(PG8_SA(0, 1), cA + hstep, voffA);
        if (wr == 1) PG8_BAR;
        PG8_WAIT_V(2); PG8_BAR;
        PG8_STAGE(PG8_SB(1, 0), cB + kstep, voffB); PG8_STAGE(PG8_SA(1, 0), cA + kstep, voffA); PG8_STAGE(PG8_SB(1, 1), cB + hstep + kstep, voffB);
        PG8_WAIT_V(6); PG8_BAR;
    } else {
        PG8_STAGE(PG8_SB(0, 0), cB, voffB); PG8_STAGE(PG8_SA(0, 0), cA, voffA); PG8_STAGE(PG8_SB(0, 1), cB + hstep, voffB); PG8_STAGE(PG8_SA(0, 1), cA + hstep, voffA);
        if (wr == 1) PG8_BAR;
        PG8_WAIT_V(4); PG8_BAR;
        PG8_STAGE(PG8_SB(1, 0), cB + kstep, voffB); PG8_STAGE(PG8_SA(1, 0), cA + kstep, voffA); PG8_STAGE(PG8_SB(1, 1), cB + hstep + kstep, voffB);
        PG8_WAIT_V(6); PG8_BAR;
    }
    for (;;) {
        const bool has_next = S.next(ui + 1, nxt);
        const char* nA = has_next ? (const char*)g.A + (size_t)nxt.pm * tstep : cA; const char* nB = has_next ? (const char*)g.Bt + (size_t)nxt.pn * tstep : cB;
        for (int t = 0; t < nt; t += 2) {
            const bool last = (t == nt - 2);
            const char* a1 = cA + (size_t)(t + 1) * kstep;
            const char* a2 = last ? nA : cA + (size_t)(t + 2) * kstep; const char* b2 = last ? nB : cB + (size_t)(t + 2) * kstep;
            const char* a3 = a2 + kstep; const char* b3 = b2 + kstep;
            if (last && has_next) S.a_ready(nxt);
            if constexpr (SP2) {
            PG8_LDB(B0, 0, 0); PG8_LDB(B1, 0, 1); PG8_SCHED; PG8_LDA(At, 0, 0); PG8_STAGE(PG8_SA(1, 1), a1 + hstep, voffA);
            PG8_WAIT_V(8); PG8_WAIT_L(0); PG8_BAR; PG8_MMA(0, 0, At, B0); PG8_MMA(0, 1, At, B1); PG8_BAR; PG8_SCHED;
            PG8_LDA(At, 0, 1); PG8_STAGE(PG8_SB(0, 0), b2, voffB); PG8_STAGE(PG8_SB(0, 1), b2 + hstep, voffB); PG8_STAGE(PG8_SA(0, 0), a2, voffA);
            PG8_WAIT_V(8); PG8_WAIT_L(0); PG8_BAR; PG8_MMA(1, 0, At, B0); PG8_MMA(1, 1, At, B1); PG8_BAR; PG8_SCHED;
            PG8_LDB(B0, 1, 0); PG8_LDB(B1, 1, 1); PG8_SCHED; PG8_LDA(At, 1, 0); PG8_STAGE(PG8_SA(0, 1), a2 + hstep, voffA);
            PG8_WAIT_V(8); PG8_WAIT_L(0); PG8_BAR; PG8_MMA(0, 0, At, B0); PG8_MMA(0, 1, At, B1); PG8_BAR; PG8_SCHED;
            PG8_LDA(At, 1, 1); PG8_STAGE(PG8_SB(1, 0), b3, voffB); PG8_STAGE(PG8_SB(1, 1), b3 + hstep, voffB); PG8_STAGE(PG8_SA(1, 0), a3, voffA);
            PG8_WAIT_V(8); PG8_WAIT_L(0); PG8_BAR; PG8_MMA(1, 0, At, B0); PG8_MMA(1, 1, At, B1); PG8_BAR; PG8_SCHED;
            } else {
            PG8_LDB(B0, 0, 0); PG8_SCHED; PG8_LDA(At, 0, 0); PG8_STAGE(PG8_SA(1, 1), a1 + hstep, voffA);
            PG8_WAIT_L(8); PG8_BAR; PG8_WAIT_L(0); PG8_MMA(0, 0, At, B0); PG8_BAR; PG8_SCHED;
            PG8_LDB(B1, 0, 1); PG8_STAGE(PG8_SB(0, 0), b2, voffB);
            PG8_BAR; PG8_WAIT_L(0); PG8_MMA(0, 1, At, B1); PG8_BAR;
            PG8_LDA(At, 0, 1); PG8_STAGE(PG8_SA(0, 0), a2, voffA);
            PG8_BAR; PG8_WAIT_L(0); PG8_MMA(1, 0, At, B0); PG8_BAR; PG8_SCHED;
            PG8_STAGE(PG8_SB(0, 1), b2 + hstep, voffB);
            PG8_WAIT_V(6); PG8_BAR; PG8_MMA(1, 1, At, B1); PG8_BAR;
            PG8_LDB(B0, 1, 0); PG8_SCHED; PG8_LDA(At, 1, 0); PG8_STAGE(PG8_SA(0, 1), a2 + hstep, voffA);
            PG8_WAIT_L(8); PG8_BAR; PG8_WAIT_L(0); PG8_MMA(0, 0, At, B0); PG8_BAR; PG8_SCHED;
            PG8_LDB(B1, 1, 1); PG8_STAGE(PG8_SB(1, 0), b3, voffB);
            PG8_BAR; PG8_WAIT_L(0); PG8_MMA(0, 1, At, B1); PG8_BAR;
            PG8_LDA(At, 1, 1); PG8_STAGE(PG8_SA(1, 0), a3, voffA);
            PG8_BAR; PG8_WAIT_L(0); PG8_MMA(1, 0, At, B0); PG8_BAR; PG8_SCHED;
            PG8_STAGE(PG8_SB(1, 1), b3 + hstep, voffB);
            PG8_WAIT_V(6); PG8_BAR; PG8_MMA(1, 1, At, B1); PG8_BAR;
            }
        }
        if constexpr (ALIGN_EPI) { if (wr == 0) PG8_BAR; }
        if constexpr (!Epi::AFTER_DRAIN) { E(acc, cur, wr, wc, fr, fq, ui); S.done(cur); }
        if (!has_next) break;
#pragma unroll
        for (int a = 0; a < 2; ++a)
#pragma unroll
            for (int b = 0; b < 2; ++b)
#pragma unroll
                for (int m = 0; m < 4; ++m)
#pragma unroll
                    for (int n = 0; n < 2; ++n) acc[a][b][m][n] = (f32x4){0.f, 0.f, 0.f, 0.f};
        cur = nxt; cA = nA; cB = nB; ++ui;
        if constexpr (ALIGN_EPI) { if (wr == 1) PG8_BAR; }
    }
    PG8_WAIT_V(0);
    if constexpr (!ALIGN_EPI) { if (wr == 0) PG8_BAR; }
    PG8_BAR;
    if constexpr (Epi::AFTER_DRAIN) { E.fused(acc, cur, wr, wc, fr, fq, lds, wid, lane); S.done(cur); }
#undef PG8_SA
#undef PG8_SB
#undef PG8_STAGE
#undef PG8_LDA
#undef PG8_LDB
#undef PG8_MMA
#undef PG8_WAIT_V
#undef PG8_WAIT_L
#undef PG8_BAR
#undef PG8_SCHED
}
}
constexpr int M = 8192, SEQ = 4096, DM = 2048, DFF = 5632;
constexpr int GLA_LD = 6160, FOX_LD = 8208;
constexpr int LD0 = 6144;
constexpr int LD1 = 8192;
constexpr int NWAVES = 8, NTHREADS = 512;
constexpr int LDS_BYTES = 151552;
constexpr size_t MiB = 1u << 20;
constexpr size_t WS_WG2 = 0, WS_BG2 = 65536, WS_OGAIN = 69632, WS_BF = 71680, WS_QGAIN = 71936, WS_KGAIN = 72448;
constexpr size_t WS_THR = 73728;
constexpr size_t WS_BAR = 131072;
constexpr size_t WS_SSQ = 1 * MiB, WS_GLR = 2 * MiB, WS_EL = 2 * MiB + 512 * 1024, WS_CF = 3 * MiB, WS_W1T = 4 * MiB, WS_WFT = 4 * MiB + 65536;
constexpr size_t WS_WGI = 8 * MiB, WS_WGO = 32 * MiB, WS_WGU0 = 40 * MiB, WS_WD0 = 84 * MiB, WS_WFI = 106 * MiB, WS_WFO = 138 * MiB, WS_WGU1 = 146 * MiB, WS_WD1 = 190 * MiB;
constexpr size_t WS_XB = 212 * MiB, WS_OB = 244 * MiB, WS_PROJ = 276 * MiB, WS_QT = 404 * MiB, WS_KDT = 420 * MiB, WS_AM = 436 * MiB, WS_ST1 = 440 * MiB, WS_END = 470 * MiB;
constexpr size_t WS_VT = WS_PROJ + 96 * MiB;
constexpr size_t WS_ST0 = WS_WGU1;

#define LAS __attribute__((address_space(3)))
typedef unsigned short bf16;
__device__ __forceinline__ bf16* st_ptr(unsigned char* ws, int pu) { return (bf16*)(ws + (pu < 392 ? WS_ST0 + (size_t)pu * 262144 : WS_ST1 + (size_t)(pu - 392) * 262144)); }
typedef unsigned v4u __attribute__((ext_vector_type(4)));
typedef unsigned v2u __attribute__((ext_vector_type(2)));
typedef float f32x4 __attribute__((ext_vector_type(4)));
typedef float f32x16 __attribute__((ext_vector_type(16)));
typedef short bf16x8 __attribute__((ext_vector_type(8)));
typedef short s16x4 __attribute__((ext_vector_type(4)));
#define SBAR() __builtin_amdgcn_sched_barrier(0)
#define LDS_WAIT() asm volatile("s_waitcnt lgkmcnt(0)" ::: "memory")
__device__ __forceinline__ unsigned f2bf(float f) { return cvtpk(f, 0.f) & 0xffffu; }
__device__ __forceinline__ unsigned pk2(float lo, float hi) { return cvtpk(lo, hi); }
__device__ __forceinline__ float bf2f(unsigned short b) { return __builtin_bit_cast(float, (unsigned)b << 16); }
__device__ __forceinline__ float wave_sum(float v) {
#pragma unroll
    for (int o = 1; o < 64; o <<= 1) v += __shfl_xor(v, o);
    return v;
}

struct Params {
    const float* x; const float* norm_mix; const float* norm_ffn; const float* gla_w_in; const float* gla_w_g2; const float* gla_b_g2; const float* gla_o_gain; const float* gla_w_o;
    const float* fox_w_in; const float* fox_b_f; const float* fox_q_gain; const float* fox_k_gain; const float* fox_w_o; const float* ffn_w_gate; const float* ffn_w_up; const float* ffn_w_down;
    float* out; unsigned char* ws; int ph_lo, ph_hi;
};

struct TJob { const float* src; const float* gain; bf16* dst; int ld, K; };
__device__ __forceinline__ void tj_load(const TJob& j, f32x4 (&v)[8]) {
#pragma unroll
    for (int r = 0; r < 8; ++r) v[r] = __builtin_nontemporal_load((const f32x4*)(j.src + (size_t)r * j.ld));
}
__device__ __forceinline__ void tj_store(const TJob& j, f32x4 (&v)[8]) {
    if (j.gain) { const f32x4 g0 = *(const f32x4*)j.gain, g1 = *(const f32x4*)(j.gain + 4);
#pragma unroll
        for (int r = 0; r < 8; ++r) v[r] = v[r] * (r < 4 ? g0[r] : g1[r - 4]); }
#pragma unroll
    for (int c = 0; c < 4; ++c) { v4u w; w.x = cvtpk(v[0][c], v[1][c]); w.y = cvtpk(v[2][c], v[3][c]); w.z = cvtpk(v[4][c], v[5][c]); w.w = cvtpk(v[6][c], v[7][c]);
        *(v4u*)(j.dst + (size_t)c * j.K) = w; }
}
__device__ __forceinline__ void p0_prologue(const Params& P, LAS unsigned char* lds, int part, int blk, int nblk_) {
    const int tid = opaque_tid(), lane = tid & 63, wave = tid >> 6;
    const int gw = blk * NWAVES + wave, NGW = nblk_ * NWAVES;
    unsigned char* ws = P.ws;
    constexpr int I_A = 32 * 192, I_B = 32 * 64, I_C = 32 * 176, I_D = 88 * 64;
    constexpr int NITEMS = 2 * I_A + 3 * I_B + 4 * I_C + 2 * I_D;
    auto decode = [&](int it) -> TJob {
        int r = it; const float* W; int ld, col0 = 0, K = 2048, nblk, mode = 0; const float* gain = nullptr; bf16* WT; int rowoff = 0;
        if (r < I_A) { W = P.gla_w_in; ld = GLA_LD; nblk = 192; gain = P.norm_mix; WT = (bf16*)(ws + WS_WGI); }
        else if ((r -= I_A) < I_B) { W = P.gla_w_o; ld = 2048; nblk = 64; WT = (bf16*)(ws + WS_WGO); }
        else if ((r -= I_B) < I_C) { W = P.ffn_w_gate; ld = DFF; nblk = 176; gain = P.norm_ffn; WT = (bf16*)(ws + WS_WGU0); mode = 1; }
        else if ((r -= I_C) < I_C) { W = P.ffn_w_up; ld = DFF; nblk = 176; gain = P.norm_ffn; WT = (bf16*)(ws + WS_WGU0); mode = 1; rowoff = 128; }
        else if ((r -= I_C) < I_D) { W = P.ffn_w_down; ld = 2048; nblk = 64; K = DFF; WT = (bf16*)(ws + WS_WD0); }
        else if ((r -= I_D) < I_A) { W = P.fox_w_in; ld = FOX_LD; nblk = 192; gain = P.norm_mix + DM; WT = (bf16*)(ws + WS_WFI); }
        else if ((r -= I_A) < I_B) { W = P.fox_w_in; ld = FOX_LD; col0 = 6160; nblk = 64; gain = P.norm_mix + DM; WT = (bf16*)(ws + WS_WFI); rowoff = 6144; }
        else if ((r -= I_B) < I_B) { W = P.fox_w_o; ld = 2048; nblk = 64; WT = (bf16*)(ws + WS_WFO); }
        else if ((r -= I_B) < I_C) { W = P.ffn_w_gate + (size_t)DM * DFF; ld = DFF; nblk = 176; gain = P.norm_ffn + DM; WT = (bf16*)(ws + WS_WGU1); mode = 1; }
        else if ((r -= I_C) < I_C) { W = P.ffn_w_up + (size_t)DM * DFF; ld = DFF; nblk = 176; gain = P.norm_ffn + DM; WT = (bf16*)(ws + WS_WGU1); mode = 1; rowoff = 128; }
        else { r -= I_C; W = P.ffn_w_down + (size_t)DFF * DM; ld = 2048; nblk = 64; K = DFF; WT = (bf16*)(ws + WS_WD1); }
        const int kb = r / nblk, nb = r % nblk, n0 = nb * 32, k0 = kb * 64 + 8 * (lane >> 3), c4 = lane & 7;
        const int drow0 = (mode ? ((n0 >> 7) * 256 + (n0 & 127)) : n0) + rowoff;
        TJob j; j.src = W + (size_t)k0 * ld + col0 + n0 + 4 * c4; j.gain = gain ? gain + k0 : nullptr; j.dst = WT + (size_t)(drow0 + 4 * c4) * K + k0; j.ld = ld; j.K = K; return j;
    };
    constexpr int NITEMS_A = I_A + I_B + 2 * I_C + I_D + I_A, NITEMS_B = NITEMS_A + 2 * I_B + 2 * I_C;
    const int it_lo = part == 0 ? 0 : (part == 1 ? NITEMS_A : NITEMS_B), it_hi = part == 0 ? NITEMS_A : (part == 1 ? NITEMS_B : NITEMS);
    { int it = it_lo + gw;
      if (it < it_hi) {
        bool h1 = it + NGW < it_hi; TJob j0 = decode(it), j1 = decode(h1 ? it + NGW : it);
        f32x4 va[8], vb[8]; tj_load(j0, va); tj_load(j1, vb);
        for (;;) {
            const int itn = it + 2 * NGW; const bool more = itn < it_hi;
            const bool h1n = more && (itn + NGW < it_hi);
            const TJob n0 = decode(more ? itn : it), n1 = decode(h1n ? itn + NGW : (more ? itn : it));
            f32x4 vc[8], vd[8];
            if (more) { tj_load(n0, vc); tj_load(n1, vd); }
            tj_store(j0, va); if (h1) tj_store(j1, vb);
            if (!more) break;
#pragma unroll
            for (int r = 0; r < 8; ++r) { va[r] = vc[r]; vb[r] = vd[r]; }
            j0 = n0; j1 = n1; h1 = h1n; it = itn;
        }
      } }
    if (part) return;
    for (int e = blockIdx.x * NTHREADS + tid; e < 65536; e += gridDim.x * NTHREADS) {
        const int which = e >> 15, idx = e & 32767, k = idx >> 4, c = idx & 15;
        const float v = which ? P.fox_w_in[(size_t)k * FOX_LD + 6144 + c] * P.norm_mix[DM + k] : P.gla_w_in[(size_t)k * GLA_LD + 6144 + c] * P.norm_mix[k];
        ((bf16*)(ws + (which ? WS_WFT : WS_W1T)))[c * 2048 + k] = (bf16)f2bf(v);
    }
    for (int e = blockIdx.x * NTHREADS + tid; e < 16384 + 1024 + 512 + 16 + 128 + 128; e += gridDim.x * NTHREADS) {
        if (e < 16384) ((float*)(ws + WS_WG2))[e] = P.gla_w_g2[e];
        else if (e < 17408) ((float*)(ws + WS_BG2))[e - 16384] = P.gla_b_g2[e - 16384];
        else if (e < 17920) ((float*)(ws + WS_OGAIN))[e - 17408] = P.gla_o_gain[e - 17408];
        else if (e < 17936) ((float*)(ws + WS_BF))[e - 17920] = P.fox_b_f[e - 17920];
        else if (e < 18064) ((float*)(ws + WS_QGAIN))[e - 17936] = P.fox_q_gain[e - 17936];
        else ((float*)(ws + WS_KGAIN))[e - 18064] = P.fox_k_gain[e - 18064];
    }
    bf16* XB = (bf16*)(ws + WS_XB); float* SSQ = (float*)(ws + WS_SSQ);
    for (int m = gw; m < M; m += NGW) {
        const f32x4* xr = (const f32x4*)(P.x + (size_t)m * DM) + lane; f32x4 v[8]; float s = 0.f;
#pragma unroll
        for (int j = 0; j < 8; ++j) { v[j] = __builtin_nontemporal_load(xr + 64 * j); s += (v[j][0] * v[j][0] + v[j][1] * v[j][1]) + (v[j][2] * v[j][2] + v[j][3] * v[j][3]); }
        s = wave_sum(s);
        v2u* o8 = (v2u*)(XB + (size_t)m * DM) + lane;
#pragma unroll
        for (int j = 0; j < 8; ++j) { v2u w; w.x = pk2(v[j][0], v[j][1]); w.y = pk2(v[j][2], v[j][3]); o8[64 * j] = w; }
        if (lane < 32) SSQ[(size_t)m * 32 + lane] = lane == 0 ? s : 0.f;
    }
}

__device__ __forceinline__ void thin_gemm(const bf16* XB, const bf16* WT, const float* SSQ, float* OUT, LAS unsigned char* lds) {
    const int tid = opaque_tid(), lane = tid & 63, wave = tid >> 6, fr = lane & 15, q = lane >> 4, grp = wave >> 2, wk = wave & 3;
    LAS f32x4* red = (LAS f32x4*)lds;
    for (int t0 = 2 * blockIdx.x; t0 < M / 16; t0 += 2 * gridDim.x) { const int tile = t0 + grp;
        f32x4 acc = {0.f, 0.f, 0.f, 0.f};
        const bf16* ap = XB + (size_t)(tile * 16 + fr) * DM + wk * 512 + q * 8; const bf16* bp = WT + (size_t)fr * DM + wk * 512 + q * 8;
        float t4[4] = {0.f, 0.f, 0.f, 0.f};
        if (wk == 0) {
#pragma unroll
            for (int i = 0; i < 4; ++i) { const f32x4* p = (const f32x4*)(SSQ + (size_t)(tile * 16 + 4 * q + i) * 32);
#pragma unroll
                for (int j = 0; j < 8; ++j) { const f32x4 a = p[j]; t4[i] += (a[0] + a[1]) + (a[2] + a[3]); } } }
#pragma unroll
        for (int kb = 0; kb < 16; ++kb) { const bf16x8 a = *(const bf16x8*)(ap + kb * 32), b = *(const bf16x8*)(bp + kb * 32); acc = __builtin_amdgcn_mfma_f32_16x16x32_bf16(a, b, acc, 0, 0, 0); }
        red[wave * 64 + lane] = acc;
        __syncthreads();
        if (wk == 0) {
            f32x4 s = red[wave * 64 + lane];
#pragma unroll
            for (int w = 1; w < 4; ++w) s += red[(wave + w) * 64 + lane];
#pragma unroll
            for (int i = 0; i < 4; ++i) OUT[(size_t)(tile * 16 + 4 * q + i) * 16 + fr] = s[i] / sqrtf(t4[i] * (1.0f / 2048.0f) + 1e-6f);
        }
        __syncthreads();
    }
}
__device__ __forceinline__ float log_sigmoid_f(float z) { return fminf(z, 0.f) - __logf(1.0f + __expf(-fabsf(z))); }
__device__ __forceinline__ void gla_prep_unit(const Params& P, LAS unsigned char* lds, int u) {
    const int tid = opaque_tid(), lane = tid & 63, wave = tid >> 6, fr = lane & 15, q4 = lane >> 4;
    const int ch = u & 63, h = (u >> 6) & 3, b = u >> 8, tok0 = b * SEQ + ch * 64;
    unsigned char* ws = P.ws;
    LAS float* Bs = (LAS float*)lds;
    LAS bf16* QS = (LAS bf16*)(lds + 65536);
    LAS bf16* KS = (LAS bf16*)(lds + 65536 + 33792);
    LAS float* GL = (LAS float*)(lds + 133120);
    LAS float* TOT = (LAS float*)(lds + 137216);
    const float* GLR = (const float*)(ws + WS_GLR); const bf16* PROJ = (const bf16*)(ws + WS_PROJ);
    bf16* QT = (bf16*)(ws + WS_QT); bf16* KDT = (bf16*)(ws + WS_KDT); bf16* AM = (bf16*)(ws + WS_AM); float* EL = (float*)(ws + WS_EL);
    v4u rq[4], rk[4];
#pragma unroll
    for (int it = 0; it < 4; ++it) { const int idx = it * NTHREADS + tid, t = idx >> 5, cc = idx & 31; const bf16* p = PROJ + (size_t)(tok0 + t) * LD0 + 256 * h + 8 * cc; rq[it] = __builtin_nontemporal_load((const v4u*)p); rk[it] = __builtin_nontemporal_load((const v4u*)(p + 1024)); }
    if (tid < 256) ((LAS f32x4*)GL)[tid] = ((const f32x4*)(GLR + (size_t)tok0 * 16))[tid];
    const int c = tid & 255, th = tid >> 8;
    float w2[16];
#pragma unroll
    for (int j = 0; j < 16; ++j) w2[j] = ((const float*)(ws + WS_WG2))[j * 1024 + 256 * h + c];
    const float bias = ((const float*)(ws + WS_BG2))[256 * h + c];
    __syncthreads();
    float cum = 0.f;
#pragma unroll 4
    for (int tt = 0; tt < 32; ++tt) { const int t = 32 * th + tt; float z = bias;
#pragma unroll
        for (int j = 0; j < 16; ++j) z += GL[t * 16 + j] * w2[j];
        cum += log_sigmoid_f(z) * (1.0f / 16.0f); Bs[t * 256 + c] = cum; }
    TOT[th * 256 + c] = cum;
#pragma unroll
    for (int it = 0; it < 4; ++it) { const int idx = it * NTHREADS + tid, t = idx >> 5, cc = idx & 31; *(LAS v4u*)(QS + t * 264 + 8 * cc) = rq[it]; *(LAS v4u*)(KS + t * 264 + 8 * cc) = rk[it]; }
    v4u rv[8];
#pragma unroll
    for (int it = 0; it < 8; ++it) { const int idx = it * NTHREADS + tid, t = idx >> 6, cc = idx & 63; rv[it] = __builtin_nontemporal_load((const v4u*)(PROJ + (size_t)(tok0 + t) * LD0 + 2048 + 512 * h + 8 * cc)); }
    __syncthreads();
    const float off = th ? TOT[c] : 0.f, blast = TOT[c] + TOT[256 + c], eblast = __expf(blast);
    for (int g8 = 0; g8 < 4; ++g8) { unsigned kdp[8];
#pragma unroll
        for (int e = 0; e < 8; ++e) { const int t = 32 * th + g8 * 8 + e; const float bb = Bs[t * 256 + c] + off;
            const float qv = bf2f(QS[t * 264 + c]), kv = bf2f(KS[t * 264 + c]);
            const float eb = __expf(bb), qt = qv * 0.0625f * eb, kt = kv * __expf(-bb), kd = kt * eblast;
            QS[t * 264 + c] = (bf16)f2bf(qt); KS[t * 264 + c] = (bf16)f2bf(kt); kdp[e] = f2bf(kd); }
        v4u o; o.x = kdp[0] | (kdp[1] << 16); o.y = kdp[2] | (kdp[3] << 16); o.z = kdp[4] | (kdp[5] << 16); o.w = kdp[6] | (kdp[7] << 16);
        *(v4u*)(KDT + ((size_t)u * 256 + c) * 64 + 32 * th + g8 * 8) = o; }
    if (th == 0) EL[(size_t)u * 256 + c] = eblast;
    __syncthreads();
    LAS bf16* VS = (LAS bf16*)lds;
#pragma unroll
    for (int it = 0; it < 8; ++it) { const int idx = it * NTHREADS + tid, t = idx >> 6, cc = idx & 63; *(LAS v4u*)(VS + t * 512 + 8 * (cc ^ ((t >> 3) & 7))) = rv[it]; }
#pragma unroll
    for (int it = 0; it < 4; ++it) { const int idx = it * NTHREADS + tid, t = idx >> 5, cc = idx & 31; *(v4u*)(QT + ((size_t)u * 64 + t) * 256 + 8 * cc) = *(const LAS v4u*)(QS + t * 264 + 8 * cc); }
#pragma unroll
    for (int rep = 0; rep < 2; ++rep) { const int idx = wave + 8 * rep, mi = idx >> 2, si = idx & 3;
        f32x4 acc = {0.f, 0.f, 0.f, 0.f};
        if (si <= mi) {
#pragma unroll
            for (int kb = 0; kb < 8; ++kb) { const bf16x8 a = *(const LAS bf16x8*)(KS + (16 * si + fr) * 264 + 32 * kb + 8 * q4), bq = *(const LAS bf16x8*)(QS + (16 * mi + fr) * 264 + 32 * kb + 8 * q4);
                acc = __builtin_amdgcn_mfma_f32_16x16x32_bf16(a, bq, acc, 0, 0, 0); }
        }
        const int t = 16 * mi + fr; float o4[4];
#pragma unroll
        for (int i = 0; i < 4; ++i) { const int s = 16 * si + 4 * q4 + i; o4[i] = (s <= t) ? acc[i] : 0.f; }
        v2u w; w.x = pk2(o4[0], o4[1]); w.y = pk2(o4[2], o4[3]);
        *(v2u*)(AM + ((size_t)u * 64 + t) * 64 + 16 * si + 4 * q4) = w; }
    __syncthreads();
    { const int vv = lane >> 3, tc = lane & 7;
#pragma unroll
      for (int i = 0; i < 8; ++i) { const int v = 64 * wave + 8 * i + vv; const LAS bf16* src = VS + (8 * tc) * 512 + (((v >> 3) ^ tc) * 8) + (v & 7); unsigned e[8];
#pragma unroll
          for (int j = 0; j < 8; ++j) e[j] = src[j * 512];
          v4u o; o.x = e[0] | (e[1] << 16); o.y = e[2] | (e[3] << 16); o.z = e[4] | (e[5] << 16); o.w = e[6] | (e[7] << 16);
          *(v4u*)((bf16*)(ws + WS_VT) + ((size_t)u * 512 + v) * 64 + 8 * tc) = o; } }
    __syncthreads();
}
__device__ __forceinline__ void gla_scan_unit(const Params& P, LAS unsigned char* lds, int u) {
    const int tid = opaque_tid(), lane = tid & 63, wave = tid >> 6, fr = lane & 15, q4 = lane >> 4;
    const int bh = u >> 5, kblk = (u >> 3) & 3, vblk = u & 7, pu0 = bh * 64;
    unsigned char* ws = P.ws;
    const bf16* kdsrc = (const bf16*)(ws + WS_KDT) + ((size_t)pu0 * 256 + 64 * kblk) * 64 + tid * 8;
    const bf16* vtsrc = (const bf16*)(ws + WS_VT) + ((size_t)pu0 * 512 + 64 * vblk) * 64 + tid * 8;
    const float* elsrc = (const float*)(ws + WS_EL) + (size_t)pu0 * 256 + 64 * kblk + 4 * (tid & 15) + (tid >> 4) * 256;
    const int wofs = (tid >> 3) * 144 + (tid & 7) * 16;
    const int kt = wave >> 1, key0 = 64 * kblk + 16 * kt, v0 = 64 * vblk + 32 * (wave & 1);
    const int kdo = (16 * kt + fr) * 144 + q4 * 16, vfo = 9216 + (32 * (wave & 1) + fr) * 144 + q4 * 16, elo = 147456 + (16 * kt + 4 * q4) * 4;
    v4u rk[8], rv[8]; f32x4 re = {0.f, 0.f, 0.f, 0.f};
#define SC_ISSUE(bt) do { _Pragma("unroll") for (int s = 0; s < 8; ++s) { rk[s] = *(const v4u*)(kdsrc + (size_t)((bt) * 8 + s) * 16384); rv[s] = *(const v4u*)(vtsrc + (size_t)((bt) * 8 + s) * 32768); } \
        if (tid < 128) re = *(const f32x4*)(elsrc + (bt) * 2048); } while (0)
#define SC_COMMIT() do { _Pragma("unroll") for (int s = 0; s < 8; ++s) { *(LAS v4u*)(lds + s * 18432 + wofs) = rk[s]; *(LAS v4u*)(lds + s * 18432 + 9216 + wofs) = rv[s]; } \
        if (tid < 128) *(LAS f32x4*)(lds + 147456 + tid * 16) = re; } while (0)
    f32x4 T0 = {0.f, 0.f, 0.f, 0.f}, T1 = {0.f, 0.f, 0.f, 0.f};
    SC_ISSUE(0); SC_COMMIT();
    __syncthreads();
    for (int bt = 0; bt < 8; ++bt) {
        if (bt + 1 < 8) SC_ISSUE(bt + 1);
#pragma unroll
        for (int s = 0; s < 8; ++s) {
            bf16* st = st_ptr(ws, pu0 + bt * 8 + s) + ((size_t)(key0 >> 4) * 512 + v0 + fr) * 16 + 4 * q4;
            { v2u w; w.x = cvtpk(T0[0], T0[1]); w.y = cvtpk(T0[2], T0[3]); *(v2u*)st = w; w.x = cvtpk(T1[0], T1[1]); w.y = cvtpk(T1[2], T1[3]); *(v2u*)(st + 16 * 16) = w; }
            const f32x4 el = *(const LAS f32x4*)(lds + elo + s * 256);
            T0 = T0 * el; T1 = T1 * el;
#pragma unroll
            for (int kb = 0; kb < 2; ++kb) { const bf16x8 kd = *(const LAS bf16x8*)(lds + s * 18432 + kdo + kb * 64);
                const bf16x8 v0f = *(const LAS bf16x8*)(lds + s * 18432 + vfo + kb * 64), v1f = *(const LAS bf16x8*)(lds + s * 18432 + vfo + 16 * 144 + kb * 64);
                T0 = __builtin_amdgcn_mfma_f32_16x16x32_bf16(kd, v0f, T0, 0, 0, 0); T1 = __builtin_amdgcn_mfma_f32_16x16x32_bf16(kd, v1f, T1, 0, 0, 0); }
        }
        __syncthreads();
        if (bt + 1 < 8) SC_COMMIT();
        __syncthreads();
    }
#undef SC_ISSUE
#undef SC_COMMIT
}
__device__ __forceinline__ void gla_out_unit(const Params& P, LAS unsigned char* lds, int u) {
    const int tid = opaque_tid(), lane = tid & 63, wave = tid >> 6, fr = lane & 15, q4 = lane >> 4;
    const int ch = u & 63, h = (u >> 6) & 3, b = u >> 8, tok0 = b * SEQ + ch * 64;
    unsigned char* ws = P.ws;
    const bf16* PROJ = (const bf16*)(ws + WS_PROJ); const bf16* QT = (const bf16*)(ws + WS_QT); const bf16* AM = (const bf16*)(ws + WS_AM); const bf16* VT = (const bf16*)(ws + WS_VT);
    bf16* OB = (bf16*)(ws + WS_OB); const bf16* ST = st_ptr(ws, u);
    LAS bf16* QS = (LAS bf16*)lds;
    LAS bf16* AS = (LAS bf16*)(lds + 33792);
    LAS float* SS = (LAS float*)(lds + 33792 + 9216);
    LAS float* RS = (LAS float*)(lds + 33792 + 9216 + 2048);
#pragma unroll
    for (int it = 0; it < 4; ++it) { const int idx = it * NTHREADS + tid, t = idx >> 5, cc = idx & 31; *(LAS v4u*)(QS + t * 264 + 8 * cc) = *(const v4u*)(QT + ((size_t)u * 64 + t) * 256 + 8 * cc); }
    { const int t = tid >> 3, cc = tid & 7; *(LAS v4u*)(AS + t * 72 + 8 * cc) = *(const v4u*)(AM + ((size_t)u * 64 + t) * 64 + 8 * cc); }
    LAS bf16* RT = (LAS bf16*)(lds + 49152);
#pragma unroll
    for (int it = 0; it < 8; ++it) { const int idx = it * NTHREADS + tid, t = idx >> 6, cc = idx & 63; const v4u rv = *(const v4u*)(PROJ + (size_t)(tok0 + t) * LD0 + 4096 + 512 * h + 8 * cc);
        LAS v2u* d = (LAS v2u*)(RT + t * 516 + 8 * cc); d[0] = (v2u){rv.x, rv.y}; d[1] = (v2u){rv.z, rv.w}; }
    __syncthreads();
    f32x4 acc[4][4];
#pragma unroll
    for (int m = 0; m < 4; ++m)
#pragma unroll
        for (int j = 0; j < 4; ++j) acc[m][j] = (f32x4){0.f, 0.f, 0.f, 0.f};
    const bf16* stp = ST + ((size_t)(q4 >> 1) * 512 + 64 * wave + fr) * 16 + 8 * (q4 & 1); const bf16* vtp = VT + ((size_t)u * 512 + 64 * wave + fr) * 64 + 8 * q4;
#pragma unroll
    for (int kb = 0; kb < 10; ++kb) { bf16x8 bfr[4], afr[4];
#pragma unroll
        for (int j = 0; j < 4; ++j) bfr[j] = kb < 8 ? __builtin_nontemporal_load((const bf16x8*)(stp + (size_t)(2 * kb) * 8192 + 16 * j * 16)) : *(const bf16x8*)(vtp + (size_t)(16 * j) * 64 + 32 * (kb - 8));
#pragma unroll
        for (int m = 0; m < 4; ++m) afr[m] = kb < 8 ? *(const LAS bf16x8*)(QS + (16 * m + fr) * 264 + 32 * kb + 8 * q4) : *(const LAS bf16x8*)(AS + (16 * m + fr) * 72 + 32 * (kb - 8) + 8 * q4);
#pragma unroll
        for (int m = 0; m < 4; ++m)
#pragma unroll
            for (int j = 0; j < 4; ++j) acc[m][j] = __builtin_amdgcn_mfma_f32_16x16x32_bf16(afr[m], bfr[j], acc[m][j], 0, 0, 0); }
#pragma unroll
    for (int m = 0; m < 4; ++m)
#pragma unroll
        for (int i = 0; i < 4; ++i) { float s = 0.f;
#pragma unroll
            for (int j = 0; j < 4; ++j) s += acc[m][j][i] * acc[m][j][i];
            s += __shfl_xor(s, 1); s += __shfl_xor(s, 2); s += __shfl_xor(s, 4); s += __shfl_xor(s, 8);
            if (fr == 0) SS[wave * 64 + 16 * m + 4 * q4 + i] = s; }
    __syncthreads();
    if (tid < 64) { float s = 0.f;
#pragma unroll
        for (int w = 0; w < 8; ++w) s += SS[w * 64 + tid];
        RS[tid] = 1.0f / sqrtf(s * (1.0f / 512.0f) + 1e-6f); }
    __syncthreads();
    const float* ogn = (const float*)(ws + WS_OGAIN); float gn[4];
#pragma unroll
    for (int j = 0; j < 4; ++j) gn[j] = ogn[64 * wave + 16 * j + fr];
#pragma unroll
    for (int m = 0; m < 4; ++m) { const f32x4 rs4 = *(const LAS f32x4*)(RS + 16 * m + 4 * q4);
#pragma unroll
        for (int i = 0; i < 4; ++i) { const int t = 16 * m + 4 * q4 + i; LAS bf16* rp = RT + t * 516 + 64 * wave + fr;
#pragma unroll
            for (int j = 0; j < 4; ++j) { const float r = bf2f(rp[16 * j]); rp[16 * j] = (bf16)f2bf(acc[m][j][i] * rs4[i] * gn[j] * (r / (1.0f + __expf(-r)))); } }
        SBAR(); }
    __syncthreads();
#pragma unroll
    for (int it = 0; it < 16; ++it) { const int idx = it * NTHREADS + tid, t = idx >> 7, cc = idx & 127; *(v2u*)(OB + (size_t)(tok0 + t) * DM + 512 * h + 4 * cc) = *(const LAS v2u*)(RT + t * 516 + 4 * cc); }
    __syncthreads();
}
constexpr float LOG2E = 1.4426950408889634f;
__device__ __forceinline__ void fox_prep(const Params& P, LAS unsigned char* lds) {
    const int tid = opaque_tid(), lane = tid & 63, wave = tid >> 6;
    unsigned char* ws = P.ws;
    const float* qgn = (const float*)(ws + WS_QGAIN); const float* kgn = (const float*)(ws + WS_KGAIN);
    const float qs = 0.08838834764831845f * LOG2E;
    if (blockIdx.x == 0 && wave == 0) { float mq = 0.f, mk = 0.f;
        for (int i = lane; i < 128; i += 64) { mq = fmaxf(mq, fabsf(qgn[i])); mk = fmaxf(mk, fabsf(kgn[i])); }
#pragma unroll
        for (int o = 1; o < 64; o <<= 1) { mq = fmaxf(mq, __shfl_xor(mq, o)); mk = fmaxf(mk, __shfl_xor(mk, o)); }
        if (lane == 0) *(float*)(ws + WS_THR) = 2.0f * (128.0f * mq * mk * qs * 1.05f) + 130.0f; }
    const float* FLR = (const float*)(ws + WS_GLR); float* CF = (float*)(ws + WS_CF);
    for (int sq = blockIdx.x; sq < 32; sq += gridDim.x) { const int b = sq >> 4, h = sq & 15; const float bf = ((const float*)(ws + WS_BF))[h];
        float v[8]; float cum = 0.f;
#pragma unroll
        for (int i = 0; i < 8; ++i) v[i] = FLR[(size_t)(b * SEQ + tid * 8 + i) * 16 + h];
#pragma unroll
        for (int i = 0; i < 8; ++i) { const float z = v[i] + bf; cum += fminf(z, 0.f) - log1pf(expf(-fabsf(z))); v[i] = cum; }
        float incl = cum;
#pragma unroll
        for (int o = 1; o < 64; o <<= 1) { const float t = __shfl_up(incl, o); if (lane >= o) incl += t; }
        LAS float* wt = (LAS float*)lds;
        if (lane == 63) wt[wave] = incl;
        __syncthreads();
        float woff = 0.f;
#pragma unroll
        for (int w = 0; w < 8; ++w) woff += (w < wave) ? wt[w] : 0.f;
        const float excl = woff + incl - cum;
        f32x4 o0, o1;
#pragma unroll
        for (int i = 0; i < 4; ++i) { o0[i] = (v[i] + excl) * LOG2E; o1[i] = (v[4 + i] + excl) * LOG2E; }
        f32x4* dst = (f32x4*)(CF + (size_t)sq * SEQ + tid * 8); dst[0] = o0; dst[1] = o1;
        __syncthreads();
    }
}
#define KSWZ(row, colB) ((row) * 256 + ((colB) ^ (((row) & 7) << 4)))
constexpr int SHM_K = 16384, SHM_V = 16384;
__device__ __forceinline__ int v_st(int k, int c) { const int kk = (k & ~0xC) | ((k & 4) << 1) | ((k & 8) >> 1); return ((kk >> 3) * 4 + (c >> 5)) * 512 + ((kk & 7) * 32 + (c & 31)) * 2; }
__device__ __forceinline__ int v_rd_base(int lane) { return ((lane & 3) << 3) | (((lane >> 2) & 3) << 6) | (((lane >> 4) & 1) << 5) | (((lane >> 5) & 1) << 8); }
constexpr int v_rd_off(int d0, int ks, int half) { return d0 * 512 + ks * 4096 + half * 2048; }
__device__ __forceinline__ int crow(int r, int hi) { return (r & 3) + 8 * (r >> 2) + 4 * hi; }
template <int KB>
__device__ __forceinline__ void qkt(f32x16& p0, f32x16& p1, const char* K_lds, int r32, int hi, const bf16x8* qs) {
    p0 = f32x16{}; p1 = f32x16{};
    const char* kb[4];
#pragma unroll
    for (int dd = 0; dd < 4; ++dd) kb[dd] = K_lds + KB * SHM_K + KSWZ(r32, (dd * 16 + hi * 8) * 2);
#pragma unroll
    for (int d0 = 0; d0 < 8; ++d0) { const char* a = kb[d0 & 3] + (d0 >> 2) * 128;
        bf16x8 b0 = *reinterpret_cast<const bf16x8*>(a);
        bf16x8 b1 = *reinterpret_cast<const bf16x8*>(a + 32 * 256);
        const bf16x8 qf = qs[d0 * 64];
        p0 = __builtin_amdgcn_mfma_f32_32x32x16_bf16(b0, qf, p0, 0, 0, 0);
        p1 = __builtin_amdgcn_mfma_f32_32x32x16_bf16(b1, qf, p1, 0, 0, 0); }
}
template <int VB>
__device__ __forceinline__ void pv_tile(f32x16* o, int vb0, bf16x8 pa0, bf16x8 pa1, bf16x8 pa2, bf16x8 pa3) {
#define TRRD(dst, off) asm volatile("ds_read_b64_tr_b16 %0, %1 offset:%2" : "=&v"(dst) : "v"(vb0), "i"(off) : "memory")
#define PV_RD(S, d0) do { constexpr int b_ = VB * SHM_V + v_rd_off(d0, 0, 0); \
        TRRD(S##l0, b_); TRRD(S##h0, b_ + 2048); TRRD(S##l1, b_ + 4096); TRRD(S##h1, b_ + 6144); TRRD(S##l2, b_ + 8192); TRRD(S##h2, b_ + 10240); TRRD(S##l3, b_ + 12288); TRRD(S##h3, b_ + 14336); } while (0)
#define PV_WAIT(n) do { asm volatile("s_waitcnt lgkmcnt(%0)" :: "i"(n) : "memory"); SBAR(); } while (0)
#define PV_MM(S, d0) do { \
        o[d0] = __builtin_amdgcn_mfma_f32_32x32x16_bf16(pa0, (bf16x8){S##l0[0], S##l0[1], S##l0[2], S##l0[3], S##h0[0], S##h0[1], S##h0[2], S##h0[3]}, o[d0], 0, 0, 0); \
        o[d0] = __builtin_amdgcn_mfma_f32_32x32x16_bf16(pa1, (bf16x8){S##l1[0], S##l1[1], S##l1[2], S##l1[3], S##h1[0], S##h1[1], S##h1[2], S##h1[3]}, o[d0], 0, 0, 0); \
        o[d0] = __builtin_amdgcn_mfma_f32_32x32x16_bf16(pa2, (bf16x8){S##l2[0], S##l2[1], S##l2[2], S##l2[3], S##h2[0], S##h2[1], S##h2[2], S##h2[3]}, o[d0], 0, 0, 0); \
        o[d0] = __builtin_amdgcn_mfma_f32_32x32x16_bf16(pa3, (bf16x8){S##l3[0], S##l3[1], S##l3[2], S##l3[3], S##h3[0], S##h3[1], S##h3[2], S##h3[3]}, o[d0], 0, 0, 0); SBAR(); } while (0)
    s16x4 Al0, Al1, Al2, Al3, Ah0, Ah1, Ah2, Ah3, Bl0, Bl1, Bl2, Bl3, Bh0, Bh1, Bh2, Bh3;
    PV_RD(A, 0); PV_RD(B, 1); PV_WAIT(8); PV_MM(A, 0);
    PV_RD(A, 2); PV_WAIT(8); PV_MM(B, 1);
    PV_RD(B, 3); PV_WAIT(8); PV_MM(A, 2);
    PV_WAIT(0); PV_MM(B, 3);
#undef PV_RD
#undef PV_WAIT
#undef PV_MM
#undef TRRD
}
__device__ __forceinline__ bf16x8 knorm8(bf16x8 x, const float* g) {
    const v4u xv = __builtin_bit_cast(v4u, x); float f[8];
#pragma unroll
    for (int e = 0; e < 4; ++e) { f[2 * e] = __builtin_bit_cast(float, xv[e] << 16); f[2 * e + 1] = __builtin_bit_cast(float, xv[e] & 0xffff0000u); }
    float s = 0.f;
#pragma unroll
    for (int e = 0; e < 8; ++e) s += f[e] * f[e];
    s += __shfl_xor(s, 1); s += __shfl_xor(s, 2); s += __shfl_xor(s, 4); s += __shfl_xor(s, 8);
    const float r = 1.0f / sqrtf(s * (1.0f / 128.0f) + 1e-6f);
    const f32x4 g0 = *(const f32x4*)g, g1 = *(const f32x4*)(g + 4);
    v4u w; w.x = cvtpk(f[0] * r * g0[0], f[1] * r * g0[1]); w.y = cvtpk(f[2] * r * g0[2], f[3] * r * g0[3]); w.z = cvtpk(f[4] * r * g1[0], f[5] * r * g1[1]); w.w = cvtpk(f[6] * r * g1[2], f[7] * r * g1[3]);
    return __builtin_bit_cast(bf16x8, w);
}
template <int BUF>
__device__ __forceinline__ void fox_tile(f32x16* o, float& m_reg, float& l_reg, const char* lds, const float* ckl, float* al_l, int vb0, const bf16x8* qr, float cq, int qpos, int kb0, bool need_mask, int r32, int hi) {
    f32x16 p0, p1;
    qkt<BUF>(p0, p1, lds + 2 * SHM_V, r32, hi, qr);
    const float* ck = ckl + kb0 + 4 * hi;
#pragma unroll
    for (int g = 0; g < 4; ++g) { const f32x4 c0 = *(const f32x4*)(ck + 8 * g), c1 = *(const f32x4*)(ck + 32 + 8 * g);
#pragma unroll
        for (int e = 0; e < 4; ++e) { p0[4 * g + e] += cq - c0[e]; p1[4 * g + e] += cq - c1[e]; } }
    if (need_mask) { const float NEG = -__builtin_inff(); const int dq = qpos - kb0 - 4 * hi;
#pragma unroll
        for (int r = 0; r < 16; ++r) { const int c = (r & 3) + 8 * (r >> 2); if (c > dq) p0[r] = NEG; if (c + 32 > dq) p1[r] = NEG; } }
    float pmax = p0[0];
#pragma unroll
    for (int r = 1; r < 16; ++r) pmax = fmaxf(pmax, p0[r]);
#pragma unroll
    for (int r = 0; r < 16; ++r) pmax = fmaxf(pmax, p1[r]);
    { auto rr = __builtin_amdgcn_permlane32_swap(__float_as_uint(pmax), __float_as_uint(pmax), false, false); pmax = fmaxf(__uint_as_float(rr[0]), __uint_as_float(rr[1])); }
    const float mn = fmaxf(m_reg, pmax), alpha = __builtin_amdgcn_exp2f(m_reg - mn); m_reg = mn;
    float ps = 0.f;
#pragma unroll
    for (int r = 0; r < 16; ++r) { p0[r] = __builtin_amdgcn_exp2f(p0[r] - mn); p1[r] = __builtin_amdgcn_exp2f(p1[r] - mn); ps += p0[r] + p1[r]; }
    { auto rr = __builtin_amdgcn_permlane32_swap(__float_as_uint(ps), __float_as_uint(ps), false, false); ps = __uint_as_float(rr[0]) + __uint_as_float(rr[1]); }
    l_reg = l_reg * alpha + ps;
    bf16x8 pa0, pa1, pa2, pa3;
#define PK4(Pv, B_, OUT) do { unsigned a0 = cvtpk(Pv[B_+0], Pv[B_+1]), a1 = cvtpk(Pv[B_+2], Pv[B_+3]); unsigned b0 = cvtpk(Pv[B_+4], Pv[B_+5]), b1 = cvtpk(Pv[B_+6], Pv[B_+7]); \
        auto r0 = __builtin_amdgcn_permlane32_swap(a0, b0, false, false); auto r1 = __builtin_amdgcn_permlane32_swap(a1, b1, false, false); \
        v4u w = {r0[0], r1[0], r0[1], r1[1]}; OUT = __builtin_bit_cast(bf16x8, w); } while (0)
    PK4(p0, 0, pa0); PK4(p0, 8, pa1); PK4(p1, 0, pa2); PK4(p1, 8, pa3);
#undef PK4
    if (__any(alpha < 1.f)) { if (hi == 0) al_l[r32] = alpha; asm volatile("s_waitcnt lgkmcnt(0)" ::: "memory");
#pragma unroll
        for (int d_ = 0; d_ < 4; ++d_)
#pragma unroll
            for (int r = 0; r < 16; ++r) o[d_][r] *= al_l[crow(r, hi)]; }
    SBAR();
    pv_tile<BUF>(o, vb0, pa0, pa1, pa2, pa3);
}
__device__ __forceinline__ void fox_attn_unit(const Params& P, char* lds, int b, int h, int qb, bool tables_loaded) {
    const int tid = opaque_tid(), wid = __builtin_amdgcn_readfirstlane(tid >> 6), lane = tid & 63, r32 = lane & 31, hi = lane >> 5;
    unsigned char* ws = P.ws; const bf16* PROJ = (const bf16*)(ws + WS_PROJ); const float* CF = (const float*)(ws + WS_CF) + (size_t)(b * 16 + h) * SEQ; bf16* OB = (bf16*)(ws + WS_OB);
    char* V_lds = lds; char* K_lds = lds + 2 * SHM_V;
    float* ckl = (float*)(lds + 2 * SHM_V + 2 * SHM_K);
    float* al_l = (float*)(lds + 2 * SHM_V + 2 * SHM_K + 16384) + wid * 64;
    const int q0 = qb * 256, qlo = q0 + wid * 32, qpos = qlo + r32;
    const bf16* Qp = PROJ + (size_t)(b * SEQ + qpos) * LD1 + h * 128 + hi * 8;
    const bf16* Kh = PROJ + (size_t)(b * SEQ) * LD1 + 2048 + h * 128; const bf16* Vh = Kh + 2048;
    bf16x8* qr = (bf16x8*)(lds + 83968 + wid * 8192) + lane;
    float* kgl = (float*)(lds + 149504);
    if (!tables_loaded && tid < 32) ((f32x4*)kgl)[tid] = ((const f32x4*)(ws + WS_KGAIN))[tid];
    {
      v4u qv[8]; float ssq = 0.f;
#pragma unroll
      for (int d0 = 0; d0 < 8; ++d0) { qv[d0] = *(const v4u*)(Qp + d0 * 16);
#pragma unroll
          for (int e = 0; e < 4; ++e) { const float a = __builtin_bit_cast(float, qv[d0][e] << 16), c = __builtin_bit_cast(float, qv[d0][e] & 0xffff0000u); ssq += a * a + c * c; } }
      ssq += __shfl_xor(ssq, 32);
      const float rq = (0.08838834764831845f * LOG2E) / sqrtf(ssq * (1.0f / 128.0f) + 1e-6f); const float* qgn = (const float*)(ws + WS_QGAIN) + hi * 8;
#pragma unroll
      for (int d0 = 0; d0 < 8; ++d0) { const f32x4 g0 = *(const f32x4*)(qgn + d0 * 16), g1 = *(const f32x4*)(qgn + d0 * 16 + 4); v4u w;
#pragma unroll
          for (int e = 0; e < 4; ++e) { const float a = __builtin_bit_cast(float, qv[d0][e] << 16), c = __builtin_bit_cast(float, qv[d0][e] & 0xffff0000u); const float ga = e < 2 ? g0[2 * e] : g1[2 * e - 4], gc = e < 2 ? g0[2 * e + 1] : g1[2 * e - 3];
              w[e] = cvtpk(a * rq * ga, c * rq * gc); }
          qr[d0 * 64] = __builtin_bit_cast(bf16x8, w); } }
    const float cq = CF[qpos];
    const int sr = tid >> 4, sc = (tid & 15) * 8, vst0 = v_st(sr, sc), vst1 = v_st(32 + sr, sc), kws = KSWZ(sr, sc * 2);
    const int vb0 = (int)(uintptr_t)V_lds + v_rd_base(lane);
    const int NT = 4 * (qb + 1);
    bf16x8 st_k0, st_k1, st_v0, st_v1;
    if (!tables_loaded) for (int i = tid; i < (q0 + 256) / 4; i += NTHREADS) ((f32x4*)ckl)[i] = ((const f32x4*)CF)[i];
#define SLOAD(t) do { const size_t r0_ = (size_t)((t) * 64 + sr) * LD1 + sc; st_k0 = *(const bf16x8*)(Kh + r0_); st_k1 = *(const bf16x8*)(Kh + r0_ + (size_t)32 * LD1); \
        st_v0 = *(const bf16x8*)(Vh + r0_); st_v1 = *(const bf16x8*)(Vh + r0_ + (size_t)32 * LD1); } while (0)
#define SWRITE(bf) do { *(bf16x8*)(K_lds + (bf) * SHM_K + kws) = knorm8(st_k0, kgl + sc); *(bf16x8*)(K_lds + (bf) * SHM_K + kws + 32 * 256) = knorm8(st_k1, kgl + sc); \
        *(bf16x8*)(V_lds + (bf) * SHM_V + vst0) = st_v0; *(bf16x8*)(V_lds + (bf) * SHM_V + vst1) = st_v1; } while (0)
    float m_reg = -1e30f, l_reg = 0.f; f32x16 o[4] = {};
    __syncthreads();
    int j_lo; { const float thr = *(const float*)(ws + WS_THR), cq0 = ckl[q0];
        const bool skip = lane < 4 * qb && ckl[64 * lane + 63] - cq0 > thr; const unsigned long long bm = __ballot(!skip); j_lo = (int)__builtin_ctzll(bm) & ~1; }
    SLOAD(NT - 1); SWRITE(0);
    __syncthreads();
    for (int t = NT - 1; t > j_lo; t -= 2) {
        SLOAD(t - 1);
        { const int kb0 = t * 64; fox_tile<0>(o, m_reg, l_reg, lds, ckl, al_l, vb0, qr, cq, qpos, kb0, kb0 + 63 > qlo, r32, hi); }
        SWRITE(1);
        __syncthreads();
        if (t - 2 > j_lo) SLOAD(t - 2);
        { const int kb0 = (t - 1) * 64; fox_tile<1>(o, m_reg, l_reg, lds, ckl, al_l, vb0, qr, cq, qpos, kb0, kb0 + 63 > qlo, r32, hi); }
        if (t - 2 > j_lo) SWRITE(0);
        __syncthreads();
    }
#undef SLOAD
#undef SWRITE
    if (hi == 0) al_l[r32] = l_reg; asm volatile("s_waitcnt lgkmcnt(0)" ::: "memory");
    bf16* stg = (bf16*)(lds + wid * 8192);
#pragma unroll
    for (int r = 0; r < 16; ++r) { const int row = crow(r, hi); const float rl = 1.0f / al_l[row];
#pragma unroll
        for (int d_ = 0; d_ < 4; ++d_) stg[row * 128 + d_ * 32 + r32] = (bf16)f2bf(o[d_][r] * rl); }
    asm volatile("s_waitcnt lgkmcnt(0)" ::: "memory");
    { const int ch = lane & 15; const bf16* ogp = PROJ + (size_t)(b * SEQ + qlo) * LD1 + 6144 + h * 128 + ch * 8; bf16* op = OB + (size_t)(b * SEQ + qlo) * DM + h * 128 + ch * 8;
#pragma unroll 2
      for (int i = 0; i < 8; ++i) { const int row = i * 4 + (lane >> 4); const v4u ov = *(const v4u*)(stg + row * 128 + ch * 8); const v4u gv = *(const v4u*)(ogp + (size_t)row * LD1); v4u w;
#pragma unroll
          for (int e = 0; e < 4; ++e) { const float o0 = __builtin_bit_cast(float, ov[e] << 16), o1 = __builtin_bit_cast(float, ov[e] & 0xffff0000u), g0 = __builtin_bit_cast(float, gv[e] << 16), g1 = __builtin_bit_cast(float, gv[e] & 0xffff0000u);
              w[e] = pk2(o0 / (1.0f + __expf(-g0)), o1 / (1.0f + __expf(-g1))); }
          *(v4u*)(op + (size_t)row * DM) = w; } }
    __syncthreads();
}
#define RLX_AGENT __ATOMIC_RELAXED, __HIP_MEMORY_SCOPE_AGENT
#define XB_TMO      128
#define XB_XCNT(j)  (256  + 64 * (j))
#define XB_XSUB(j)  (1280 + 64 * (j))
#define XB_XGEN(j)  (2304 + 64 * (j))
#define XB_TOP      3328
#define XB_TOPGEN   3392
#define XCD_BAR_WORDS 3456
#define XB_SPIN_CAP (1u << 18)

__device__ __forceinline__ unsigned xb_ld(unsigned* p)              { return __hip_atomic_load(p, __ATOMIC_RELAXED, __HIP_MEMORY_SCOPE_AGENT); }
__device__ __forceinline__ unsigned xb_add(unsigned* p, unsigned v) { return __hip_atomic_fetch_add(p, v, __ATOMIC_RELAXED, __HIP_MEMORY_SCOPE_AGENT); }
__device__ __forceinline__ unsigned xb_xcc_id() { return (unsigned)__builtin_amdgcn_s_getreg((3 << 11) | 20) & 0xFu; }
#define XB_SPIN(cond, bar) do { unsigned _sp = 0; while (cond) { __builtin_amdgcn_s_sleep(1); \
    if ((++_sp & 255u) == 0u) { if (xb_ld(&(bar)[XB_TMO])) break; if (_sp > XB_SPIN_CAP) { atomicAdd(&(bar)[XB_TMO], 1u); break; } } } } while (0)

struct XcdBarrier {
    unsigned* bar; unsigned x;
    volatile LAS unsigned* st;
};

__device__ __forceinline__ XcdBarrier xcd_barrier_post(unsigned* bar, volatile LAS unsigned* st) {
    XcdBarrier b; b.bar = bar; b.x = xb_xcc_id(); b.st = st;
    if (threadIdx.x == 0) (void)xb_add(&bar[XB_XCNT(b.x)], 1u);
    return b;
}
__device__ __forceinline__ void xcd_barrier_complete(unsigned* bar, unsigned x, unsigned& nloc, unsigned& nx) {
    const unsigned G = gridDim.x * gridDim.y * gridDim.z;
    unsigned sum, cnt, mine, sp = 0u;
    for (;;) {
        sum = 0u; cnt = 0u; mine = 0u;
#pragma unroll
        for (unsigned j = 0; j < 16; ++j) { const unsigned c = xb_ld(&bar[XB_XCNT(j)]); sum += c; cnt += (c > 0u) ? 1u : 0u; mine = (j == x) ? c : mine; }
        if (sum == G) break;
        __builtin_amdgcn_s_sleep(1);
        if ((++sp & 255u) == 0u) { if (xb_ld(&bar[XB_TMO])) break; if (sp > XB_SPIN_CAP) { atomicAdd(&bar[XB_TMO], 1u); break; } }
    }
    nloc = mine > 0u ? mine : 1u; nx = cnt > 0u ? cnt : 1u;
}

__device__ __forceinline__ void xcd_barrier(const XcdBarrier& b) {
    asm volatile("s_waitcnt vmcnt(0)" ::: "memory");
    __syncthreads();
    if (threadIdx.x == 0) {
        unsigned* bar = b.bar;
        __builtin_amdgcn_s_waitcnt(0);
        unsigned nloc = b.st[0], nx = b.st[1];
        if (nloc == 0u) { xcd_barrier_complete(bar, b.x, nloc, nx); b.st[0] = nloc; b.st[1] = nx; }
        const unsigned old = xb_add(&bar[XB_XSUB(b.x)], 1u);
        const unsigned gen = old / nloc;
        if (old + 1u == (gen + 1u) * nloc) {
            __builtin_amdgcn_fence(__ATOMIC_RELEASE, "agent");
            asm volatile("s_waitcnt vmcnt(0)" ::: "memory");
            const unsigned og = xb_add(&bar[XB_TOP], 1u);
            const unsigned tg = og / nx;
            if (og + 1u == (tg + 1u) * nx) xb_add(&bar[XB_TOPGEN], 1u);
            else XB_SPIN(xb_ld(&bar[XB_TOPGEN]) == tg, bar);
            __builtin_amdgcn_fence(__ATOMIC_ACQUIRE, "agent");
            xb_add(&bar[XB_XGEN(b.x)], 1u);
            asm volatile("s_waitcnt vmcnt(0)" ::: "memory");
        } else {
            XB_SPIN(xb_ld(&bar[XB_XGEN(b.x)]) == gen, bar);
            __builtin_amdgcn_fence(__ATOMIC_ACQUIRE, "agent");
            asm volatile("s_waitcnt vmcnt(0)" ::: "memory");
        }
    }
    __syncthreads();
}
constexpr int N_PHASES = 14;
#ifndef MK_MULTI
#define MK_MULTI 0
#endif
__global__ void __launch_bounds__(NTHREADS, 2) hybrid_fwd(Params P) {
    extern __shared__ __attribute__((aligned(16))) unsigned char lds_raw[];
    LAS unsigned char* lds = (LAS unsigned char*)lds_raw;
    cg::grid_group grid = cg::this_grid();
    unsigned char* ws = P.ws;
    volatile LAS unsigned* bst = (volatile LAS unsigned*)(lds + LDS_BYTES - 64);
    if (threadIdx.x == 0) { bst[0] = 0u; bst[1] = 0u; }
    __syncthreads();
    XcdBarrier xbar = xcd_barrier_post((unsigned*)(ws + WS_BAR), bst);
    const int vcu = (gridDim.x % 8 == 0) ? (int)((blockIdx.x % 8) * (gridDim.x / 8) + blockIdx.x / 8) : (int)blockIdx.x;
#if MK_MULTI
    const int lo = P.ph_lo, hi = P.ph_hi;
#else
    constexpr int lo = 0, hi = 14;
#endif
    bf16* XB = (bf16*)(ws + WS_XB); bf16* OB = (bf16*)(ws + WS_OB); bf16* PROJ = (bf16*)(ws + WS_PROJ); float* SSQ = (float*)(ws + WS_SSQ); float* GLR = (float*)(ws + WS_GLR);
#ifndef PHM
#define PHM 0x3fff
#endif
#define IN(k) ((((PHM) >> (k)) & 1) && lo <= (k) && (k) < hi)
#ifndef DUP
#define DUP -1
#endif
#define SEAM(k) do { if (IN(k) && IN((k) + 1)) xcd_barrier(xbar); } while (0)
    if (P.ph_hi < 0) grid.sync();
    for (int rep_ = 0; rep_ < (DUP == 0 ? 2 : 1); ++rep_)
    if (IN(0)) { p0_prologue(P, lds, 0, blockIdx.x, gridDim.x); } SEAM(0);
    if (IN(1)) {
        pg8::Gemm g{XB, (const bf16*)(ws + WS_WGI), M, 6144, DM}; pg8::StaticOrder S; S.init(M, 6144, gridDim.x, blockIdx.x);
        PG8_LAS float* rst = (PG8_LAS float*)(lds + 131072); pg8::fill_rstd_table(rst, SSQ, S);
        pg8::EpiScaleBf16 E{PROJ, LD0, rst};
        pg8::gemm_phase<pg8::EpiScaleBf16, pg8::StaticOrder, true, true>(lds, g, S, E);
        thin_gemm(XB, (const bf16*)(ws + WS_W1T), SSQ, GLR, lds);
    } SEAM(1);
    for (int rep_ = 0; rep_ < (DUP == 2 ? 2 : 1); ++rep_)
    if (IN(2)) { for (int u = blockIdx.x; u < 512; u += gridDim.x) gla_prep_unit(P, lds, u); } SEAM(2);
    for (int rep_ = 0; rep_ < (DUP == 3 ? 2 : 1); ++rep_)
    if (IN(3)) { for (int u = blockIdx.x; u < 256; u += gridDim.x) gla_scan_unit(P, lds, u); } SEAM(3);
    for (int rep_ = 0; rep_ < (DUP == 4 ? 2 : 1); ++rep_)
    if (IN(4)) { for (int u = blockIdx.x; u < 512; u += gridDim.x) gla_out_unit(P, lds, u); } SEAM(4);
#ifdef SYNCX
    for (int rep_ = 0; rep_ < SYNCX; ++rep_) xcd_barrier(xbar);
#endif
    for (int rep_ = 0; rep_ < (DUP == 5 ? 2 : 1); ++rep_)
    if (IN(5)) {
        pg8::Gemm g{OB, (const bf16*)(ws + WS_WGO), M, DM, DM}; pg8::StaticOrder S; S.init(M, DM, gridDim.x, blockIdx.x);
        pg8::EpiResid<0> E{P.x, P.out, XB, SSQ};
        pg8::gemm_phase<pg8::EpiResid<0>, pg8::StaticOrder, true, true>(lds, g, S, E);
    } SEAM(5);
    for (int rep_ = 0; rep_ < (DUP == 6 ? 2 : 1); ++rep_)
    if (IN(6)) {
        const int ngemm = (gridDim.x == 256 && DUP != 6) ? 235 : (int)gridDim.x;
        if ((int)blockIdx.x < ngemm) {
        pg8::Gemm g{XB, (const bf16*)(ws + WS_WGU0), M, 2 * DFF, DM}; pg8::StaticOrder S; S.init(M, 2 * DFF, ngemm, blockIdx.x);
        PG8_LAS float* rst = (PG8_LAS float*)(lds + 131072); pg8::fill_rstd_table(rst, SSQ, S);
        pg8::EpiSwiGLU E{PROJ, DFF, rst};
        pg8::gemm_phase<pg8::EpiSwiGLU, pg8::StaticOrder, true, true>(lds, g, S, E);
        if (ngemm == (int)gridDim.x && rep_ == 0) p0_prologue(P, lds, 1, blockIdx.x, gridDim.x);
        } else p0_prologue(P, lds, 1, blockIdx.x - ngemm, gridDim.x - ngemm);
    } SEAM(6);
    if (IN(7)) {
        pg8::Gemm g{PROJ, (const bf16*)(ws + WS_WD0), M, DM, DFF}; pg8::StaticOrder S; S.init(M, DM, gridDim.x, blockIdx.x);
        pg8::EpiResid<1> E{nullptr, P.out, XB, SSQ};
        pg8::gemm_phase<pg8::EpiResid<1>, pg8::StaticOrder, true, true>(lds, g, S, E);
    } SEAM(7);
    if (IN(8)) {
        pg8::Gemm g{XB, (const bf16*)(ws + WS_WFI), M, 8192, DM}; pg8::StaticOrder S; S.init(M, 8192, gridDim.x, blockIdx.x);
        PG8_LAS float* rst = (PG8_LAS float*)(lds + 131072); pg8::fill_rstd_table(rst, SSQ, S);
        pg8::EpiScaleBf16 E{PROJ, LD1, rst};
        pg8::gemm_phase<pg8::EpiScaleBf16, pg8::StaticOrder, true, true>(lds, g, S, E);
        thin_gemm(XB, (const bf16*)(ws + WS_WFT), SSQ, GLR, lds);
    } SEAM(8);
    if (IN(9)) { fox_prep(P, lds); } SEAM(9);
    for (int rep_ = 0; rep_ < (DUP == 10 ? 2 : 1); ++rep_)
    if (IN(10)) {
        for (int pr = vcu; pr < 256; pr += gridDim.x) { const int bh = pr >> 3, s = pr & 7;
            fox_attn_unit(P, (char*)lds_raw, bh >> 4, bh & 15, 2 * s + 1, false); fox_attn_unit(P, (char*)lds_raw, bh >> 4, bh & 15, 2 * s, true); }
    } SEAM(10);
    if (IN(11)) {
        pg8::Gemm g{OB, (const bf16*)(ws + WS_WFO), M, DM, DM}; pg8::StaticOrder S; S.init(M, DM, gridDim.x, blockIdx.x);
        pg8::EpiResid<1> E{nullptr, P.out, XB, SSQ};
        pg8::gemm_phase<pg8::EpiResid<1>, pg8::StaticOrder, true, true>(lds, g, S, E);
    } SEAM(11);
    if (IN(12)) {
        const int ngemm = gridDim.x == 256 ? 235 : (int)gridDim.x;
        if ((int)blockIdx.x < ngemm) {
        pg8::Gemm g{XB, (const bf16*)(ws + WS_WGU1), M, 2 * DFF, DM}; pg8::StaticOrder S; S.init(M, 2 * DFF, ngemm, blockIdx.x);
        PG8_LAS float* rst = (PG8_LAS float*)(lds + 131072); pg8::fill_rstd_table(rst, SSQ, S);
        pg8::EpiSwiGLU E{PROJ, DFF, rst};
        pg8::gemm_phase<pg8::EpiSwiGLU, pg8::StaticOrder, true, true>(lds, g, S, E);
        if (ngemm == (int)gridDim.x) p0_prologue(P, lds, 2, blockIdx.x, gridDim.x);
        } else p0_prologue(P, lds, 2, blockIdx.x - ngemm, gridDim.x - ngemm);
    } SEAM(12);
    if (IN(13)) {
        pg8::Gemm g{PROJ, (const bf16*)(ws + WS_WD1), M, DM, DFF}; pg8::StaticOrder S; S.init(M, DM, gridDim.x, blockIdx.x);
        pg8::EpiResid<2> E{nullptr, P.out, XB, SSQ};
        pg8::gemm_phase<pg8::EpiResid<2>, pg8::StaticOrder, true, true>(lds, g, S, E);
    }
#undef IN
#undef SEAM
}

extern "C" void kernel_launch(void* const* d_in, const int* in_sizes, int n_in, void* d_out, int out_size, void* d_ws, size_t ws_size, hipStream_t stream) {
    static int grid = 0;
    if (grid == 0) {
        if (n_in != 16 || in_sizes[0] != M * DM || out_size != M * DM || ws_size < WS_END) { fprintf(stderr, "kernel_launch: unexpected shapes/workspace (n_in %d, ws %zu, need %zu)\n", n_in, ws_size, (size_t)WS_END); grid = -1; return; }
        int dev = 0, cus = 0, per_cu = 0;
        hipGetDevice(&dev); hipDeviceGetAttribute(&cus, hipDeviceAttributeMultiprocessorCount, dev);
        if (hipFuncSetAttribute((const void*)hybrid_fwd, hipFuncAttributeMaxDynamicSharedMemorySize, LDS_BYTES) != hipSuccess) { fprintf(stderr, "kernel_launch: hipFuncSetAttribute failed\n"); grid = -1; return; }
        if (hipOccupancyMaxActiveBlocksPerMultiprocessor(&per_cu, (const void*)hybrid_fwd, NTHREADS, LDS_BYTES) != hipSuccess || per_cu < 1) { fprintf(stderr, "kernel_launch: occupancy query gives %d\n", per_cu); per_cu = 1; (void)hipGetLastError(); }
        grid = cus * per_cu;
        fprintf(stderr, "kernel_launch: grid %d (%d CUs x %d)\n", grid, cus, per_cu);
    }
    if (grid < 0) return;
    if (hipMemsetAsync((char*)d_ws + WS_BAR, 0, 16384, stream) != hipSuccess) { fprintf(stderr, "kernel_launch: memset failed\n"); return; }
    Params p{};
    const float* const* in = (const float* const*)d_in;
    p.x = in[0]; p.norm_mix = in[1]; p.norm_ffn = in[2]; p.gla_w_in = in[3]; p.gla_w_g2 = in[4]; p.gla_b_g2 = in[5]; p.gla_o_gain = in[6]; p.gla_w_o = in[7];
    p.fox_w_in = in[8]; p.fox_b_f = in[9]; p.fox_q_gain = in[10]; p.fox_k_gain = in[11]; p.fox_w_o = in[12]; p.ffn_w_gate = in[13]; p.ffn_w_up = in[14]; p.ffn_w_down = in[15];
    p.out = (float*)d_out; p.ws = (unsigned char*)d_ws;
#if MK_MULTI
    for (int ph = 0; ph < N_PHASES; ++ph) { p.ph_lo = ph; p.ph_hi = ph + 1; hipLaunchKernelGGL(hybrid_fwd, dim3(grid), dim3(NTHREADS), LDS_BYTES, stream, p); }
#else
    p.ph_lo = 0; p.ph_hi = N_PHASES;
    void* args[] = {&p};
    hipError_t e = hipLaunchCooperativeKernel((const void*)hybrid_fwd, dim3(grid), dim3(NTHREADS), args, LDS_BYTES, stream);
    if (e != hipSuccess) fprintf(stderr, "cooperative launch failed: %s (grid %d)\n", hipGetErrorString(e), grid);
#endif
}
```

```cpp
#include <hip/hip_runtime.h>
#include <hip/hip_cooperative_groups.h>
#include <cstdio>
#include <cstdint>
namespace cg = cooperative_groups;
__device__ __forceinline__ int opaque_tid() { int t = threadIdx.x; asm volatile("" : "+v"(t)); return t; }
typedef float f32x2_t __attribute__((ext_vector_type(2))); typedef __bf16 bf16x2_t __attribute__((ext_vector_type(2)));
__device__ __forceinline__ unsigned cvtpk(float lo, float hi) { f32x2_t v = {lo, hi}; bf16x2_t b = __builtin_convertvector(v, bf16x2_t); return __builtin_bit_cast(unsigned, b); }
namespace pg8 {
#define PG8_LAS __attribute__((address_space(3)))
typedef unsigned short bf16_t;
typedef short bf16x8 __attribute__((ext_vector_type(8)));
typedef float f32x4 __attribute__((ext_vector_type(4)));
typedef unsigned u32x4 __attribute__((ext_vector_type(4)));
constexpr int BM = 256, BK = 64, HALF = 128, HTB = HALF * BK * 2  , STAGE_BYTES = 8 * HTB, NXCD = 8, WGM = 8;

__host__ __device__ __forceinline__ int lds_byte(int r, int c) { const int st = (r >> 4) * 2 + (c >> 5), rr = r & 15, cc = c & 31, ob = rr * 64 + cc * 2; return st * 1024 + (ob ^ (((ob >> 9) & 1) << 5)); }
__host__ __device__ __forceinline__ void stage_rc(int b, int& R, int& C) { const int st = b / 1024, sb = b % 1024, swz = sb ^ (((sb >> 9) & 1) << 5); R = (st >> 1) * 16 + swz / 64; C = (st & 1) * 32 + (swz % 64) / 2; }
__host__ __device__ __forceinline__ int perm32(int rho) { const int n = rho >> 4, i = rho & 15; return 8 * (i >> 2) + 4 * n + (i & 3); }

struct Unit { int pm, pn; };
struct Gemm { const bf16_t* A; const bf16_t* Bt; int M, N, K; };

struct StaticOrder {
    int nM, nN, nwg, G, c;
    __host__ __device__ void init(int M, int N, int G_, int c_) { nM = M / BM; nN = N / BM; nwg = nM * nN; G = G_; c = c_; }
    __host__ __device__ bool next(int i, Unit& u) const {
        const long L = (long)i * G + c; if (L >= nwg) return false;
        int wgid = (int)L; { const int q = nwg / NXCD, r = nwg % NXCD, xcd = wgid % NXCD, off = wgid / NXCD; wgid = (xcd < r ? xcd * (q + 1) : r * (q + 1) + (xcd - r) * q) + off; }
        const int nig = WGM * nN, gid = wgid / nig, fm = gid * WGM, gsz = (nM - fm) < WGM ? (nM - fm) : WGM;
        u.pm = fm + ((wgid % nig) % gsz); u.pn = (wgid % nig) / gsz; return true;
    }
    __device__ __forceinline__ void a_ready(const Unit&) const {}
    __device__ __forceinline__ void done(const Unit&) const {}
};

typedef unsigned u32x2 __attribute__((ext_vector_type(2)));
__device__ __forceinline__ unsigned cvt_pk_bf16(float lo, float hi) { return ::cvtpk(lo, hi); }
constexpr float RMS_EPS = 1e-6f;
__device__ __forceinline__ void row_rstd(const float* ssq, int row0, int fq, float (&rs)[2][4]) {
#pragma unroll
    for (int ai = 0; ai < 2; ++ai)
#pragma unroll
        for (int m = 0; m < 4; ++m) { const f32x4* p = (const f32x4*)(ssq + (size_t)(row0 + ai * HALF + m * 16) * 32 + fq * 8); const f32x4 a = p[0], b = p[1];
            float s = ((a[0] + a[1]) + (a[2] + a[3])) + ((b[0] + b[1]) + (b[2] + b[3])); s += __shfl_xor(s, 16); s += __shfl_xor(s, 32);
            rs[ai][m] = 1.0f / sqrtf(s * (1.0f / 2048.0f) + RMS_EPS); }
}
__device__ __forceinline__ void rstd_from_table(const PG8_LAS float* t, float (&rs)[2][4]) {
#pragma unroll
    for (int ai = 0; ai < 2; ++ai)
#pragma unroll
        for (int m = 0; m < 4; ++m) rs[ai][m] = t[ai * HALF + m * 16];
}
template <class Sched> __device__ __forceinline__ void fill_rstd_table(PG8_LAS float* tab, const float* ssq, const Sched& S) {
    const int tid = threadIdx.x, r = tid >> 1, hf = tid & 1; Unit u;
    for (int i = 0; S.next(i, u); ++i) { const f32x4* p = (const f32x4*)(ssq + (size_t)(u.pm * BM + r) * 32 + hf * 16); float s = 0.f;
#pragma unroll
        for (int j = 0; j < 4; ++j) { const f32x4 a = p[j]; s += (a[0] + a[1]) + (a[2] + a[3]); }
        s += __shfl_xor(s, 1);
        if (hf == 0) tab[i * 256 + r] = 1.0f / sqrtf(s * (1.0f / 2048.0f) + RMS_EPS); }
    __syncthreads();
}
struct EpiScaleBf16 {
    static constexpr bool PERM = true, AFTER_DRAIN = false;
    bf16_t* O; int ldc; const PG8_LAS float* rst;
    __device__ __forceinline__ void operator()(const f32x4 (&acc)[2][2][4][2], const Unit& u, int wr, int wc, int fr, int fq, int ui) const {
        const int row0 = u.pm * BM + wr * 64 + fr, col0 = u.pn * BM + wc * 32 + 8 * fq;
        float rs[2][4]; rstd_from_table(rst + ui * 256 + wr * 64 + fr, rs);
#pragma unroll
        for (int ai = 0; ai < 2; ++ai)
#pragma unroll
            for (int m = 0; m < 4; ++m) { bf16_t* rowp = O + (size_t)(row0 + ai * HALF + m * 16) * ldc + col0; const float r = rs[ai][m];
#pragma unroll
                for (int bj = 0; bj < 2; ++bj) { const f32x4 v0 = acc[ai][bj][m][0] * r, v1 = acc[ai][bj][m][1] * r;
                    u32x4 w; w.x = cvt_pk_bf16(v0[0], v0[1]); w.y = cvt_pk_bf16(v0[2], v0[3]); w.z = cvt_pk_bf16(v1[0], v1[1]); w.w = cvt_pk_bf16(v1[2], v1[3]);
                    *(u32x4*)(rowp + bj * HALF) = w; } }
    }
};
__device__ __forceinline__ float silu_f(float g) { return g * __builtin_amdgcn_rcpf(1.0f + __expf(-g)); }
struct EpiSwiGLU {
    static constexpr bool PERM = true, AFTER_DRAIN = false;
    bf16_t* O; int ldc; const PG8_LAS float* rst;
    __device__ __forceinline__ void operator()(const f32x4 (&acc)[2][2][4][2], const Unit& u, int wr, int wc, int fr, int fq, int ui) const {
        const int row0 = u.pm * BM + wr * 64 + fr, col0 = u.pn * HALF + wc * 32 + 8 * fq;
        float rs[2][4]; rstd_from_table(rst + ui * 256 + wr * 64 + fr, rs);
#pragma unroll
        for (int ai = 0; ai < 2; ++ai)
#pragma unroll
            for (int m = 0; m < 4; ++m) { bf16_t* rowp = O + (size_t)(row0 + ai * HALF + m * 16) * ldc + col0; const float r = rs[ai][m];
                float o[8];
#pragma unroll
                for (int n = 0; n < 2; ++n)
#pragma unroll
                    for (int e = 0; e < 4; ++e) { const float g = acc[ai][0][m][n][e] * r, up = acc[ai][1][m][n][e] * r; o[n * 4 + e] = silu_f(g) * up; }
                u32x4 w; w.x = cvt_pk_bf16(o[0], o[1]); w.y = cvt_pk_bf16(o[2], o[3]); w.z = cvt_pk_bf16(o[4], o[5]); w.w = cvt_pk_bf16(o[6], o[7]);
                *(u32x4*)rowp = w; }
    }
};
template <int MODE> struct EpiResid {
    static constexpr bool PERM = false, AFTER_DRAIN = false;
    const float* base; float* out; bf16_t* xb; float* ssq;
    __device__ __forceinline__ void operator()(const f32x4 (&acc)[2][2][4][2], const Unit& u, int wr, int wc, int fr, int fq, int) const {
        const int row0 = u.pm * BM + wr * 64 + fr, col0 = u.pn * BM + wc * 32 + 4 * fq;
#pragma unroll
        for (int ai = 0; ai < 2; ++ai)
#pragma unroll
            for (int m = 0; m < 4; ++m) { const int row = row0 + ai * HALF + m * 16; const size_t off = (size_t)row * 2048 + col0; float s = 0.f;
#pragma unroll
                for (int bj = 0; bj < 2; ++bj)
#pragma unroll
                    for (int n = 0; n < 2; ++n) { const size_t o2 = off + bj * HALF + n * 16; f32x4 bs;
                        if (MODE == 0) bs = __builtin_nontemporal_load((const f32x4*)(base + o2));
                        else { const u32x2 b2 = *(const u32x2*)(xb + o2); bs[0] = __builtin_bit_cast(float, b2.x << 16); bs[1] = __builtin_bit_cast(float, b2.x & 0xffff0000u); bs[2] = __builtin_bit_cast(float, b2.y << 16); bs[3] = __builtin_bit_cast(float, b2.y & 0xffff0000u); }
                        const f32x4 o = bs + acc[ai][bj][m][n];
                        if (MODE == 2) __builtin_nontemporal_store(o, (f32x4*)(out + o2));
                        else { s += (o[0] * o[0] + o[1] * o[1]) + (o[2] * o[2] + o[3] * o[3]); u32x2 w; w.x = cvt_pk_bf16(o[0], o[1]); w.y = cvt_pk_bf16(o[2], o[3]); *(u32x2*)(xb + o2) = w; } }
                if (MODE != 2) { s += __shfl_xor(s, 16); s += __shfl_xor(s, 32); if (fq == 0) ssq[(size_t)row * 32 + u.pn * 4 + wc] = s; } }
    }
};
template <class Epi, class Sched, bool ALIGN_EPI = false, bool SP2 = false>
__device__ __forceinline__ void gemm_phase(PG8_LAS unsigned char* lds, const Gemm g, const Sched& S, const Epi& E) {
    const int tid = opaque_tid(), wid = __builtin_amdgcn_readfirstlane(tid >> 6), lane = tid & 63, wr = wid >> 2, wc = wid & 3, fr = lane & 15, fq = lane >> 4;
    const int K = g.K, nt = K / BK;
    unsigned voffA[2], voffB[2];
#pragma unroll
    for (int i = 0; i < 2; ++i) { int R, C; stage_rc(tid * 16 + i * 8192, R, C); const int Rb = Epi::PERM ? ((R & ~31) + perm32(R & 31)) : R;
        voffA[i] = (unsigned)(R * K + C) * 2u; voffB[i] = (unsigned)(Rb * K + C) * 2u; }
    const size_t kstep = (size_t)(BK * 2);
    const size_t hstep = (size_t)HALF * K * 2;
    const size_t tstep = 2 * hstep;
    const unsigned ldsw = (unsigned)wid * 1024u;
    const int aoff = lds_byte(wr * 64 + fr, fq * 8), boff = lds_byte(wc * 32 + fr, fq * 8);
#define PG8_SA(b, h) (((b) * 2 + (h)) * HTB)
#define PG8_SB(b, h) ((4 + (b) * 2 + (h)) * HTB)
#define PG8_STAGE(bufoff, gbase, voff) do { _Pragma("unroll") for (int _i = 0; _i < 2; ++_i) \
        __builtin_amdgcn_global_load_lds((const unsigned*)((const char*)(gbase) + (voff)[_i]), (PG8_LAS unsigned*)(lds + (bufoff) + ldsw + _i * 8192), 16, 0, 0); } while (0)
#define PG8_LDA(dst, b, h) do { _Pragma("unroll") for (int m = 0; m < 4; ++m) _Pragma("unroll") for (int k = 0; k < 2; ++k) dst[m][k] = *(const PG8_LAS bf16x8*)(lds + PG8_SA(b, h) + aoff + m * 2048 + k * 1024); } while (0)
#define PG8_LDB(dst, b, h) do { _Pragma("unroll") for (int n = 0; n < 2; ++n) _Pragma("unroll") for (int k = 0; k < 2; ++k) dst[n][k] = *(const PG8_LAS bf16x8*)(lds + PG8_SB(b, h) + boff + n * 2048 + k * 1024); } while (0)
#define PG8_MMA(ai, bj, At, Bt) do { __builtin_amdgcn_s_setprio(1); _Pragma("unroll") for (int m = 0; m < 4; ++m) _Pragma("unroll") for (int n = 0; n < 2; ++n) _Pragma("unroll") for (int k = 0; k < 2; ++k) \
        acc[ai][bj][m][n] = __builtin_amdgcn_mfma_f32_16x16x32_bf16(Bt[n][k], At[m][k], acc[ai][bj][m][n], 0, 0, 0); __builtin_amdgcn_s_setprio(0); } while (0)
#define PG8_WAIT_V(n) asm volatile("s_waitcnt vmcnt(" #n ")" ::: "memory")
#define PG8_WAIT_L(n) asm volatile("s_waitcnt lgkmcnt(" #n ")" ::: "memory")
#define PG8_BAR __builtin_amdgcn_s_barrier()
#define PG8_SCHED __builtin_amdgcn_sched_barrier(0)
    Unit cur, nxt; int ui = 0;
    if (!S.next(0, cur)) return;
    f32x4 acc[2][2][4][2];
#pragma unroll
    for (int a = 0; a < 2; ++a)
#pragma unroll
        for (int b = 0; b < 2; ++b)
#pragma unroll
            for (int m = 0; m < 4; ++m)
#pragma unroll
                for (int n = 0; n < 2; ++n) acc[a][b][m][n] = (f32x4){0.f, 0.f, 0.f, 0.f};
    bf16x8 At[4][2], B0[2][2], B1[2][2];
    const char* cA = (const char*)g.A + (size_t)cur.pm * tstep; const char* cB = (const char*)g.Bt + (size_t)cur.pn * tstep;
    S.a_ready(cur);
    if constexpr (SP2) {
        PG8_STAGE(PG8_SB(0, 0), cB, voffB); PG8_STAGE(PG8_SB(0, 1), cB + hstep, voffB); PG8_STAGE(PG8_SA(0, 0), cA, voffA); PG8_STAGE(PG8_SA(0, 1), cA + hstep, voffA);
        if (wr == 1) PG8_BAR;
        PG8_WAIT_V(2); PG8_BAR;
        PG8_STAGE(PG8_SB(1, 0), cB + kstep, voffB); PG8_STAGE(PG8_SA(1, 0), cA + kstep, voffA); PG8_STAGE(PG8_SB(1, 1), cB + hstep + kstep, voffB);
        PG8_WAIT_V(6); PG8_BAR;
    } else {
        PG8_STAGE(PG8_SB(0, 0), cB, voffB); PG8_STAGE(PG8_SA(0, 0), cA, voffA); PG8_STAGE(PG8_SB(0, 1), cB + hstep, voffB); PG8_STAGE(PG8_SA(0, 1), cA + hstep, voffA);
        if (wr == 1) PG8_BAR;
        PG8_WAIT_V(4); PG8_BAR;
        PG8_STAGE(PG8_SB(1, 0), cB + kstep, voffB); PG8_STAGE(PG8_SA(1, 0), cA + kstep, voffA); PG8_STAGE(PG8_SB(1, 1), cB + hstep + kstep, voffB);
        PG8_WAIT_V(6); PG8_BAR;
    }
    for (;;) {
        const bool has_next = S.next(ui + 1, nxt);
        const char* nA = has_next ? (const char*)g.A + (size_t)nxt.pm * tstep : cA; const char* nB = has_next ? (const char*)g.Bt + (size_t)nxt.pn * tstep : cB;
        for (int t = 0; t < nt; t += 2) {
            const bool last = (t == nt - 2);
            const char* a1 = cA + (size_t)(t + 1) * kstep;
            const char* a2 = last ? nA : cA + (size_t)(t + 2) * kstep; const char* b2 = last ? nB : cB + (size_t)(t + 2) * kstep;
            const char* a3 = a2 + kstep; const char* b3 = b2 + kstep;
            if (last && has_next) S.a_ready(nxt);
            if constexpr (SP2) {
            PG8_LDB(B0, 0, 0); PG8_LDB(B1, 0, 1); PG8_SCHED; PG8_LDA(At, 0, 0); PG8_STAGE(PG8_SA(1, 1), a1 + hstep, voffA);
            PG8_WAIT_V(8); PG8_WAIT_L(0); PG8_BAR; PG8_MMA(0, 0, At, B0); PG8_MMA(0, 1, At, B1); PG8_BAR; PG8_SCHED;
            PG8_LDA(At, 0, 1); PG8_STAGE(PG8_SB(0, 0), b2, voffB); PG8_STAGE(PG8_SB(0, 1), b2 + hstep, voffB); PG8_STAGE(PG8_SA(0, 0), a2, voffA);
            PG8_WAIT_V(8); PG8_WAIT_L(0); PG8_BAR; PG8_MMA(1, 0, At, B0); PG8_MMA(1, 1, At, B1); PG8_BAR; PG8_SCHED;
            PG8_LDB(B0, 1, 0); PG8_LDB(B1, 1, 1); PG8_SCHED; PG8_LDA(At, 1, 0); PG8_STAGE(PG8_SA(0, 1), a2 + hstep, voffA);
            PG8_WAIT_V(8); PG8_WAIT_L(0); PG8_BAR; PG8_MMA(0, 0, At, B0); PG8_MMA(0, 1, At, B1); PG8_BAR; PG8_SCHED;
            PG8_LDA(At, 1, 1); PG8_STAGE(PG8_SB(1, 0), b3, voffB); PG8_STAGE(PG8_SB(1, 1), b3 + hstep, voffB); PG8_STAGE(PG8_SA(1, 0), a3, voffA);
            PG8_WAIT_V(8); PG8_WAIT_L(0); PG8_BAR; PG8_MMA(1, 0, At, B0); PG8_MMA(1, 1, At, B1); PG8_BAR; PG8_SCHED;
            } else {
            PG8_LDB(B0, 0, 0); PG8_SCHED; PG8_LDA(At, 0, 0); PG8_STAGE(PG8_SA(1, 1), a1 + hstep, voffA);
            PG8_WAIT_L(8); PG8_BAR; PG8_WAIT_L(0); PG8_MMA(0, 0, At, B0); PG8_BAR; PG8_SCHED;
            PG8_LDB(B1, 0, 1); PG8_STAGE(PG8_SB(0, 0), b2, voffB);
            PG8_BAR; PG8_WAIT_L(0); PG8_MMA(0, 1, At, B1); PG8_BAR;
            PG8_LDA(At, 0, 1); PG8_STAGE(PG8_SA(0, 0), a2, voffA);
            PG8_BAR; PG8_WAIT_L(0); PG8_MMA(1, 0, At, B0); PG8_BAR; PG8_SCHED;
            PG8_STAGE(PG8_SB(0, 1), b2 + hstep, voffB);
            PG8_WAIT_V(6); PG8_BAR; PG8_MMA(1, 1, At, B1); PG8_BAR;
            PG8_LDB(B0, 1, 0); PG8_SCHED; PG8_LDA(At, 1, 0); PG8_STAGE(PG8_SA(0, 1), a2 + hstep, voffA);
            PG8_WAIT_L(8); PG8_BAR; PG8_WAIT_L(0); PG8_MMA(0, 0, At, B0); PG8_BAR; PG8_SCHED;
            PG8_LDB(B1, 1, 1); PG8_STAGE(PG8_SB(1, 0), b3, voffB);
            PG8_BAR; PG8_WAIT_L(0); PG8_MMA(0, 1, At, B1); PG8_BAR;
            PG8_LDA(At, 1, 1); PG8_STAGE(PG8_SA(1, 0), a3, voffA);
            PG8_BAR; PG8_WAIT_L(0); PG8_MMA(1, 0, At, B0); PG8_BAR; PG8_SCHED;
            PG8_STAGE(PG8_SB(1, 1), b3 + hstep, voffB);
            PG8_WAIT_V(6); PG8_BAR; PG8_MMA(1, 1, At, B1); PG8_BAR;
            }
        }
        if constexpr (ALIGN_EPI) { if (wr == 0) PG8_BAR; }
        if constexpr (!Epi::AFTER_DRAIN) { E(acc, cur, wr, wc, fr, fq, ui); S.done(cur); }
        if (!has_next) break;
#pragma unroll
        for (int a = 0; a < 2; ++a)
#pragma unroll
            for (int b = 0; b < 2; ++b)
#pragma unroll
                for (int m = 0; m < 4; ++m)
#pragma unroll
                    for (int n = 0; n < 2; ++n) acc[a][b][m][n] = (f32x4){0.f, 0.f, 0.f, 0.f};
        cur = nxt; cA = nA; cB = nB; ++ui;
        if constexpr (ALIGN_EPI) { if (wr == 1) PG8_BAR; }
    }
    PG8_WAIT_V(0);
    if constexpr (!ALIGN_EPI) { if (wr == 0) PG8_BAR; }
    PG8_BAR;
    if constexpr (Epi::AFTER_DRAIN) { E.fused(acc, cur, wr, wc, fr, fq, lds, wid, lane); S.done(cur); }
#undef PG8_SA
#undef PG8_SB
#undef PG8_STAGE
#undef PG8_LDA
#undef PG8_LDB
#undef PG8_MMA
#undef PG8_WAIT_V
#undef PG8_WAIT_L
#undef PG8_BAR
#undef PG8_SCHED
}
}
constexpr int M = 8192, SEQ = 4096, DM = 2048, DFF = 5632;
constexpr int GLA_LD = 6160, FOX_LD = 8208;
constexpr int LD0 = 6144;
constexpr int LD1 = 8192;
constexpr int NWAVES = 8, NTHREADS = 512;
constexpr int LDS_BYTES = 151552;
constexpr size_t MiB = 1u << 20;
constexpr size_t WS_WG2 = 0, WS_BG2 = 65536, WS_OGAIN = 69632, WS_BF = 71680, WS_QGAIN = 71936, WS_KGAIN = 72448;
constexpr size_t WS_THR = 73728;
constexpr size_t WS_BAR = 131072;
constexpr size_t WS_SSQ = 1 * MiB, WS_GLR = 2 * MiB, WS_EL = 2 * MiB + 512 * 1024, WS_CF = 3 * MiB, WS_W1T = 4 * MiB, WS_WFT = 4 * MiB + 65536;
constexpr size_t WS_WGI = 8 * MiB, WS_WGO = 32 * MiB, WS_WGU0 = 40 * MiB, WS_WD0 = 84 * MiB, WS_WFI = 106 * MiB, WS_WFO = 138 * MiB, WS_WGU1 = 146 * MiB, WS_WD1 = 190 * MiB;
constexpr size_t WS_XB = 212 * MiB, WS_OB = 244 * MiB, WS_PROJ = 276 * MiB, WS_QT = 404 * MiB, WS_KDT = 420 * MiB, WS_AM = 436 * MiB, WS_ST1 = 440 * MiB, WS_END = 470 * MiB;
constexpr size_t WS_VT = WS_PROJ + 96 * MiB;
constexpr size_t WS_ST0 = WS_WGU1;

#define LAS __attribute__((address_space(3)))
typedef unsigned short bf16;
__device__ __forceinline__ bf16* st_ptr(unsigned char* ws, int pu) { return (bf16*)(ws + (pu < 392 ? WS_ST0 + (size_t)pu * 262144 : WS_ST1 + (size_t)(pu - 392) * 262144)); }
typedef unsigned v4u __attribute__((ext_vector_type(4)));
typedef unsigned v2u __attribute__((ext_vector_type(2)));
typedef float f32x4 __attribute__((ext_vector_type(4)));
typedef float f32x16 __attribute__((ext_vector_type(16)));
typedef short bf16x8 __attribute__((ext_vector_type(8)));
typedef short s16x4 __attribute__((ext_vector_type(4)));
#define SBAR() __builtin_amdgcn_sched_barrier(0)
#define LDS_WAIT() asm volatile("s_waitcnt lgkmcnt(0)" ::: "memory")
__device__ __forceinline__ unsigned f2bf(float f) { return cvtpk(f, 0.f) & 0xffffu; }
__device__ __forceinline__ unsigned pk2(float lo, float hi) { return cvtpk(lo, hi); }
__device__ __forceinline__ float bf2f(unsigned short b) { return __builtin_bit_cast(float, (unsigned)b << 16); }
__device__ __forceinline__ float wave_sum(float v) {
#pragma unroll
    for (int o = 1; o < 64; o <<= 1) v += __shfl_xor(v, o);
    return v;
}

struct Params {
    const float* x; const float* norm_mix; const float* norm_ffn; const float* gla_w_in; const float* gla_w_g2; const float* gla_b_g2; const float* gla_o_gain; const float* gla_w_o;
    const float* fox_w_in; const float* fox_b_f; const float* fox_q_gain; const float* fox_k_gain; const float* fox_w_o; const float* ffn_w_gate; const float* ffn_w_up; const float* ffn_w_down;
    float* out; unsigned char* ws; int ph_lo, ph_hi;
};

struct TJob { const float* src; const float* gain; bf16* dst; int ld, K; };
__device__ __forceinline__ void tj_load(const TJob& j, f32x4 (&v)[8]) {
#pragma unroll
    for (int r = 0; r < 8; ++r) v[r] = __builtin_nontemporal_load((const f32x4*)(j.src + (size_t)r * j.ld));
}
__device__ __forceinline__ void tj_store(const TJob& j, f32x4 (&v)[8]) {
    if (j.gain) { const f32x4 g0 = *(const f32x4*)j.gain, g1 = *(const f32x4*)(j.gain + 4);
#pragma unroll
        for (int r = 0; r < 8; ++r) v[r] = v[r] * (r < 4 ? g0[r] : g1[r - 4]); }
#pragma unroll
    for (int c = 0; c < 4; ++c) { v4u w; w.x = cvtpk(v[0][c], v[1][c]); w.y = cvtpk(v[2][c], v[3][c]); w.z = cvtpk(v[4][c], v[5][c]); w.w = cvtpk(v[6][c], v[7][c]);
        *(v4u*)(j.dst + (size_t)c * j.K) = w; }
}
__device__ __forceinline__ void p0_prologue(const Params& P, LAS unsigned char* lds, int part, int blk, int nblk_) {
    const int tid = opaque_tid(), lane = tid & 63, wave = tid >> 6;
    const int gw = blk * NWAVES + wave, NGW = nblk_ * NWAVES;
    unsigned char* ws = P.ws;
    constexpr int I_A = 32 * 192, I_B = 32 * 64, I_C = 32 * 176, I_D = 88 * 64;
    constexpr int NITEMS = 2 * I_A + 3 * I_B + 4 * I_C + 2 * I_D;
    auto decode = [&](int it) -> TJob {
        int r = it; const float* W; int ld, col0 = 0, K = 2048, nblk, mode = 0; const float* gain = nullptr; bf16* WT; int rowoff = 0;
        if (r < I_A) { W = P.gla_w_in; ld = GLA_LD; nblk = 192; gain = P.norm_mix; WT = (bf16*)(ws + WS_WGI); }
        else if ((r -= I_A) < I_B) { W = P.gla_w_o; ld = 2048; nblk = 64; WT = (bf16*)(ws + WS_WGO); }
        else if ((r -= I_B) < I_C) { W = P.ffn_w_gate; ld = DFF; nblk = 176; gain = P.norm_ffn; WT = (bf16*)(ws + WS_WGU0); mode = 1; }
        else if ((r -= I_C) < I_C) { W = P.ffn_w_up; ld = DFF; nblk = 176; gain = P.norm_ffn; WT = (bf16*)(ws + WS_WGU0); mode = 1; rowoff = 128; }
        else if ((r -= I_C) < I_D) { W = P.ffn_w_down; ld = 2048; nblk = 64; K = DFF; WT = (bf16*)(ws + WS_WD0); }
        else if ((r -= I_D) < I_A) { W = P.fox_w_in; ld = FOX_LD; nblk = 192; gain = P.norm_mix + DM; WT = (bf16*)(ws + WS_WFI); }
        else if ((r -= I_A) < I_B) { W = P.fox_w_in; ld = FOX_LD; col0 = 6160; nblk = 64; gain = P.norm_mix + DM; WT = (bf16*)(ws + WS_WFI); rowoff = 6144; }
        else if ((r -= I_B) < I_B) { W = P.fox_w_o; ld = 2048; nblk = 64; WT = (bf16*)(ws + WS_WFO); }
        else if ((r -= I_B) < I_C) { W = P.ffn_w_gate + (size_t)DM * DFF; ld = DFF; nblk = 176; gain = P.norm_ffn + DM; WT = (bf16*)(ws + WS_WGU1); mode = 1; }
        else if ((r -= I_C) < I_C) { W = P.ffn_w_up + (size_t)DM * DFF; ld = DFF; nblk = 176; gain = P.norm_ffn + DM; WT = (bf16*)(ws + WS_WGU1); mode = 1; rowoff = 128; }
        else { r -= I_C; W = P.ffn_w_down + (size_t)DFF * DM; ld = 2048; nblk = 64; K = DFF; WT = (bf16*)(ws + WS_WD1); }
        const int kb = r / nblk, nb = r % nblk, n0 = nb * 32, k0 = kb * 64 + 8 * (lane >> 3), c4 = lane & 7;
        const int drow0 = (mode ? ((n0 >> 7) * 256 + (n0 & 127)) : n0) + rowoff;
        TJob j; j.src = W + (size_t)k0 * ld + col0 + n0 + 4 * c4; j.gain = gain ? gain + k0 : nullptr; j.dst = WT + (size_t)(drow0 + 4 * c4) * K + k0; j.ld = ld; j.K = K; return j;
    };
    constexpr int NITEMS_A = I_A + I_B + 2 * I_C + I_D + I_A, NITEMS_B = NITEMS_A + 2 * I_B + 2 * I_C;
    const int it_lo = part == 0 ? 0 : (part == 1 ? NITEMS_A : NITEMS_B), it_hi = part == 0 ? NITEMS_A : (part == 1 ? NITEMS_B : NITEMS);
    { int it = it_lo + gw;
      if (it < it_hi) {
        bool h1 = it + NGW < it_hi; TJob j0 = decode(it), j1 = decode(h1 ? it + NGW : it);
        f32x4 va[8], vb[8]; tj_load(j0, va); tj_load(j1, vb);
        for (;;) {
            const int itn = it + 2 * NGW; const bool more = itn < it_hi;
            const bool h1n = more && (itn + NGW < it_hi);
            const TJob n0 = decode(more ? itn : it), n1 = decode(h1n ? itn + NGW : (more ? itn : it));
            f32x4 vc[8], vd[8];
            if (more) { tj_load(n0, vc); tj_load(n1, vd); }
            tj_store(j0, va); if (h1) tj_store(j1, vb);
            if (!more) break;
#pragma unroll
            for (int r = 0; r < 8; ++r) { va[r] = vc[r]; vb[r] = vd[r]; }
            j0 = n0; j1 = n1; h1 = h1n; it = itn;
        }
      } }
    if (part) return;
    for (int e = blockIdx.x * NTHREADS + tid; e < 65536; e += gridDim.x * NTHREADS) {
        const int which = e >> 15, idx = e & 32767, k = idx >> 4, c = idx & 15;
        const float v = which ? P.fox_w_in[(size_t)k * FOX_LD + 6144 + c] * P.norm_mix[DM + k] : P.gla_w_in[(size_t)k * GLA_LD + 6144 + c] * P.norm_mix[k];
        ((bf16*)(ws + (which ? WS_WFT : WS_W1T)))[c * 2048 + k] = (bf16)f2bf(v);
    }
    for (int e = blockIdx.x * NTHREADS + tid; e < 16384 + 1024 + 512 + 16 + 128 + 128; e += gridDim.x * NTHREADS) {
        if (e < 16384) ((float*)(ws + WS_WG2))[e] = P.gla_w_g2[e];
        else if (e < 17408) ((float*)(ws + WS_BG2))[e - 16384] = P.gla_b_g2[e - 16384];
        else if (e < 17920) ((float*)(ws + WS_OGAIN))[e - 17408] = P.gla_o_gain[e - 17408];
        else if (e < 17936) ((float*)(ws + WS_BF))[e - 17920] = P.fox_b_f[e - 17920];
        else if (e < 18064) ((float*)(ws + WS_QGAIN))[e - 17936] = P.fox_q_gain[e - 17936];
        else ((float*)(ws + WS_KGAIN))[e - 18064] = P.fox_k_gain[e - 18064];
    }
    bf16* XB = (bf16*)(ws + WS_XB); float* SSQ = (float*)(ws + WS_SSQ);
    for (int m = gw; m < M; m += 2 * NGW) {
        const int m1 = m + NGW; const bool h1 = m1 < M;
        const f32x4* xr0 = (const f32x4*)(P.x + (size_t)m * DM) + lane; const f32x4* xr1 = (const f32x4*)(P.x + (size_t)(h1 ? m1 : m) * DM) + lane;
        f32x4 v0[8], v1[8]; float s0 = 0.f, s1 = 0.f;
#pragma unroll
        for (int j = 0; j < 8; ++j) { v0[j] = __builtin_nontemporal_load(xr0 + 64 * j); v1[j] = __builtin_nontemporal_load(xr1 + 64 * j); }
#pragma unroll
        for (int j = 0; j < 8; ++j) { s0 += (v0[j][0] * v0[j][0] + v0[j][1] * v0[j][1]) + (v0[j][2] * v0[j][2] + v0[j][3] * v0[j][3]); s1 += (v1[j][0] * v1[j][0] + v1[j][1] * v1[j][1]) + (v1[j][2] * v1[j][2] + v1[j][3] * v1[j][3]); }
        s0 = wave_sum(s0); s1 = wave_sum(s1);
        v2u* o0 = (v2u*)(XB + (size_t)m * DM) + lane;
#pragma unroll
        for (int j = 0; j < 8; ++j) { v2u w; w.x = pk2(v0[j][0], v0[j][1]); w.y = pk2(v0[j][2], v0[j][3]); o0[64 * j] = w; }
        if (lane < 32) SSQ[(size_t)m * 32 + lane] = lane == 0 ? s0 : 0.f;
        if (h1) { v2u* o1 = (v2u*)(XB + (size_t)m1 * DM) + lane;
#pragma unroll
            for (int j = 0; j < 8; ++j) { v2u w; w.x = pk2(v1[j][0], v1[j][1]); w.y = pk2(v1[j][2], v1[j][3]); o1[64 * j] = w; }
            if (lane < 32) SSQ[(size_t)m1 * 32 + lane] = lane == 0 ? s1 : 0.f; }
    }
}

__device__ __forceinline__ void thin_gemm(const bf16* XB, const bf16* WT, const float* SSQ, float* OUT, LAS unsigned char* lds) {
    const int tid = opaque_tid(), lane = tid & 63, wave = tid >> 6, fr = lane & 15, q = lane >> 4, grp = wave >> 2, wk = wave & 3;
    LAS f32x4* red = (LAS f32x4*)lds;
    for (int t0 = 2 * blockIdx.x; t0 < M / 16; t0 += 2 * gridDim.x) { const int tile = t0 + grp;
        f32x4 acc = {0.f, 0.f, 0.f, 0.f};
        const bf16* ap = XB + (size_t)(tile * 16 + fr) * DM + wk * 512 + q * 8; const bf16* bp = WT + (size_t)fr * DM + wk * 512 + q * 8;
        float t4[4] = {0.f, 0.f, 0.f, 0.f};
        if (wk == 0) {
#pragma unroll
            for (int i = 0; i < 4; ++i) { const f32x4* p = (const f32x4*)(SSQ + (size_t)(tile * 16 + 4 * q + i) * 32);
#pragma unroll
                for (int j = 0; j < 8; ++j) { const f32x4 a = p[j]; t4[i] += (a[0] + a[1]) + (a[2] + a[3]); } } }
#pragma unroll
        for (int kb = 0; kb < 16; ++kb) { const bf16x8 a = *(const bf16x8*)(ap + kb * 32), b = *(const bf16x8*)(bp + kb * 32); acc = __builtin_amdgcn_mfma_f32_16x16x32_bf16(a, b, acc, 0, 0, 0); }
        red[wave * 64 + lane] = acc;
        __syncthreads();
        if (wk == 0) {
            f32x4 s = red[wave * 64 + lane];
#pragma unroll
            for (int w = 1; w < 4; ++w) s += red[(wave + w) * 64 + lane];
#pragma unroll
            for (int i = 0; i < 4; ++i) OUT[(size_t)(tile * 16 + 4 * q + i) * 16 + fr] = s[i] / sqrtf(t4[i] * (1.0f / 2048.0f) + 1e-6f);
        }
        __syncthreads();
    }
}
__device__ __forceinline__ float log_sigmoid_f(float z) { return fminf(z, 0.f) - __logf(1.0f + __expf(-fabsf(z))); }
__device__ __forceinline__ void gla_prep_unit(const Params& P, LAS unsigned char* lds, int u) {
    const int tid = opaque_tid(), lane = tid & 63, wave = tid >> 6, fr = lane & 15, q4 = lane >> 4;
    const int ch = u & 63, h = (u >> 6) & 3, b = u >> 8, tok0 = b * SEQ + ch * 64;
    unsigned char* ws = P.ws;
    LAS float* Bs = (LAS float*)lds;
    LAS bf16* QS = (LAS bf16*)(lds + 65536);
    LAS bf16* KS = (LAS bf16*)(lds + 65536 + 33792);
    LAS float* GL = (LAS float*)(lds + 133120);
    LAS float* TOT = (LAS float*)(lds + 137216);
    const float* GLR = (const float*)(ws + WS_GLR); const bf16* PROJ = (const bf16*)(ws + WS_PROJ);
    bf16* QT = (bf16*)(ws + WS_QT); bf16* KDT = (bf16*)(ws + WS_KDT); bf16* AM = (bf16*)(ws + WS_AM); float* EL = (float*)(ws + WS_EL);
    v4u rq[4], rk[4];
#pragma unroll
    for (int it = 0; it < 4; ++it) { const int idx = it * NTHREADS + tid, t = idx >> 5, cc = idx & 31; const bf16* p = PROJ + (size_t)(tok0 + t) * LD0 + 256 * h + 8 * cc; rq[it] = __builtin_nontemporal_load((const v4u*)p); rk[it] = __builtin_nontemporal_load((const v4u*)(p + 1024)); }
    if (tid < 256) ((LAS f32x4*)GL)[tid] = ((const f32x4*)(GLR + (size_t)tok0 * 16))[tid];
    const int c = tid & 255, th = tid >> 8;
    float w2[16];
#pragma unroll
    for (int j = 0; j < 16; ++j) w2[j] = ((const float*)(ws + WS_WG2))[j * 1024 + 256 * h + c];
    const float bias = ((const float*)(ws + WS_BG2))[256 * h + c];
    __syncthreads();
    float cum = 0.f;
#pragma unroll 4
    for (int tt = 0; tt < 32; ++tt) { const int t = 32 * th + tt; float z = bias;
#pragma unroll
        for (int j = 0; j < 16; ++j) z += GL[t * 16 + j] * w2[j];
        cum += log_sigmoid_f(z) * (1.0f / 16.0f); Bs[t * 256 + c] = cum; }
    TOT[th * 256 + c] = cum;
#pragma unroll
    for (int it = 0; it < 4; ++it) { const int idx = it * NTHREADS + tid, t = idx >> 5, cc = idx & 31; *(LAS v4u*)(QS + t * 264 + 8 * cc) = rq[it]; *(LAS v4u*)(KS + t * 264 + 8 * cc) = rk[it]; }
    v4u rv[8];
#pragma unroll
    for (int it = 0; it < 8; ++it) { const int idx = it * NTHREADS + tid, t = idx >> 6, cc = idx & 63; rv[it] = __builtin_nontemporal_load((const v4u*)(PROJ + (size_t)(tok0 + t) * LD0 + 2048 + 512 * h + 8 * cc)); }
    __syncthreads();
    const float off = th ? TOT[c] : 0.f, blast = TOT[c] + TOT[256 + c], eblast = __expf(blast);
    for (int g8 = 0; g8 < 4; ++g8) { unsigned kdp[8];
#pragma unroll
        for (int e = 0; e < 8; ++e) { const int t = 32 * th + g8 * 8 + e; const float bb = Bs[t * 256 + c] + off;
            const float qv = bf2f(QS[t * 264 + c]), kv = bf2f(KS[t * 264 + c]);
            const float eb = __expf(bb), qt = qv * 0.0625f * eb, kt = kv * __expf(-bb), kd = kt * eblast;
            QS[t * 264 + c] = (bf16)f2bf(qt); KS[t * 264 + c] = (bf16)f2bf(kt); kdp[e] = f2bf(kd); }
        v4u o; o.x = kdp[0] | (kdp[1] << 16); o.y = kdp[2] | (kdp[3] << 16); o.z = kdp[4] | (kdp[5] << 16); o.w = kdp[6] | (kdp[7] << 16);
        *(v4u*)(KDT + ((size_t)u * 256 + c) * 64 + 32 * th + g8 * 8) = o; }
    if (th == 0) EL[(size_t)u * 256 + c] = eblast;
    __syncthreads();
    LAS bf16* VS = (LAS bf16*)lds;
#pragma unroll
    for (int it = 0; it < 8; ++it) { const int idx = it * NTHREADS + tid, t = idx >> 6, cc = idx & 63; *(LAS v4u*)(VS + t * 512 + 8 * (cc ^ ((t >> 3) & 7))) = rv[it]; }
#pragma unroll
    for (int it = 0; it < 4; ++it) { const int idx = it * NTHREADS + tid, t = idx >> 5, cc = idx & 31; *(v4u*)(QT + ((size_t)u * 64 + t) * 256 + 8 * cc) = *(const LAS v4u*)(QS + t * 264 + 8 * cc); }
#pragma unroll
    for (int rep = 0; rep < 2; ++rep) { const int idx = wave + 8 * rep, mi = idx >> 2, si = idx & 3;
        f32x4 acc = {0.f, 0.f, 0.f, 0.f};
        if (si <= mi) {
#pragma unroll
            for (int kb = 0; kb < 8; ++kb) { const bf16x8 a = *(const LAS bf16x8*)(KS + (16 * si + fr) * 264 + 32 * kb + 8 * q4), bq = *(const LAS bf16x8*)(QS + (16 * mi + fr) * 264 + 32 * kb + 8 * q4);
                acc = __builtin_amdgcn_mfma_f32_16x16x32_bf16(a, bq, acc, 0, 0, 0); }
        }
        const int t = 16 * mi + fr; float o4[4];
#pragma unroll
        for (int i = 0; i < 4; ++i) { const int s = 16 * si + 4 * q4 + i; o4[i] = (s <= t) ? acc[i] : 0.f; }
        v2u w; w.x = pk2(o4[0], o4[1]); w.y = pk2(o4[2], o4[3]);
        *(v2u*)(AM + ((size_t)u * 64 + t) * 64 + 16 * si + 4 * q4) = w; }
    __syncthreads();
    { const int vv = lane >> 3, tc = lane & 7;
#pragma unroll
      for (int i = 0; i < 8; ++i) { const int v = 64 * wave + 8 * i + vv; const LAS bf16* src = VS + (8 * tc) * 512 + (((v >> 3) ^ tc) * 8) + (v & 7); unsigned e[8];
#pragma unroll
          for (int j = 0; j < 8; ++j) e[j] = src[j * 512];
          v4u o; o.x = e[0] | (e[1] << 16); o.y = e[2] | (e[3] << 16); o.z = e[4] | (e[5] << 16); o.w = e[6] | (e[7] << 16);
          *(v4u*)((bf16*)(ws + WS_VT) + ((size_t)u * 512 + v) * 64 + 8 * tc) = o; } }
    __syncthreads();
}
__device__ __forceinline__ void gla_scan_unit(const Params& P, LAS unsigned char* lds, int u) {
    const int tid = opaque_tid(), lane = tid & 63, wave = tid >> 6, fr = lane & 15, q4 = lane >> 4;
    const int bh = u >> 5, kblk = (u >> 3) & 3, vblk = u & 7, pu0 = bh * 64;
    unsigned char* ws = P.ws;
    const bf16* kdsrc = (const bf16*)(ws + WS_KDT) + ((size_t)pu0 * 256 + 64 * kblk) * 64 + tid * 8;
    const bf16* vtsrc = (const bf16*)(ws + WS_VT) + ((size_t)pu0 * 512 + 64 * vblk) * 64 + tid * 8;
    const float* elsrc = (const float*)(ws + WS_EL) + (size_t)pu0 * 256 + 64 * kblk + 4 * (tid & 15) + (tid >> 4) * 256;
    const int wofs = (tid >> 3) * 144 + (tid & 7) * 16;
    const int kt = wave >> 1, key0 = 64 * kblk + 16 * kt, v0 = 64 * vblk + 32 * (wave & 1);
    const int kdo = (16 * kt + fr) * 144 + q4 * 16, vfo = 9216 + (32 * (wave & 1) + fr) * 144 + q4 * 16, elo = 147456 + (16 * kt + 4 * q4) * 4;
    v4u rk[8], rv[8]; f32x4 re = {0.f, 0.f, 0.f, 0.f};
#define SC_ISSUE(bt) do { _Pragma("unroll") for (int s = 0; s < 8; ++s) { rk[s] = *(const v4u*)(kdsrc + (size_t)((bt) * 8 + s) * 16384); rv[s] = *(const v4u*)(vtsrc + (size_t)((bt) * 8 + s) * 32768); } \
        if (tid < 128) re = *(const f32x4*)(elsrc + (bt) * 2048); } while (0)
#define SC_COMMIT() do { _Pragma("unroll") for (int s = 0; s < 8; ++s) { *(LAS v4u*)(lds + s * 18432 + wofs) = rk[s]; *(LAS v4u*)(lds + s * 18432 + 9216 + wofs) = rv[s]; } \
        if (tid < 128) *(LAS f32x4*)(lds + 147456 + tid * 16) = re; } while (0)
    f32x4 T0 = {0.f, 0.f, 0.f, 0.f}, T1 = {0.f, 0.f, 0.f, 0.f};
    SC_ISSUE(0); SC_COMMIT();
    __syncthreads();
    for (int bt = 0; bt < 8; ++bt) {
        if (bt + 1 < 8) SC_ISSUE(bt + 1);
#pragma unroll
        for (int s = 0; s < 8; ++s) {
            bf16* st = st_ptr(ws, pu0 + bt * 8 + s) + ((size_t)(key0 >> 4) * 512 + v0 + fr) * 16 + 4 * q4;
            { v2u w; w.x = cvtpk(T0[0], T0[1]); w.y = cvtpk(T0[2], T0[3]); *(v2u*)st = w; w.x = cvtpk(T1[0], T1[1]); w.y = cvtpk(T1[2], T1[3]); *(v2u*)(st + 16 * 16) = w; }
            const f32x4 el = *(const LAS f32x4*)(lds + elo + s * 256);
            T0 = T0 * el; T1 = T1 * el;
#pragma unroll
            for (int kb = 0; kb < 2; ++kb) { const bf16x8 kd = *(const LAS bf16x8*)(lds + s * 18432 + kdo + kb * 64);
                const bf16x8 v0f = *(const LAS bf16x8*)(lds + s * 18432 + vfo + kb * 64), v1f = *(const LAS bf16x8*)(lds + s * 18432 + vfo + 16 * 144 + kb * 64);
                T0 = __builtin_amdgcn_mfma_f32_16x16x32_bf16(kd, v0f, T0, 0, 0, 0); T1 = __builtin_amdgcn_mfma_f32_16x16x32_bf16(kd, v1f, T1, 0, 0, 0); }
        }
        __syncthreads();
        if (bt + 1 < 8) SC_COMMIT();
        __syncthreads();
    }
#undef SC_ISSUE
#undef SC_COMMIT
}
__device__ __forceinline__ void gla_out_unit(const Params& P, LAS unsigned char* lds, int u) {
    const int tid = opaque_tid(), lane = tid & 63, wave = tid >> 6, fr = lane & 15, q4 = lane >> 4;
    const int ch = u & 63, h = (u >> 6) & 3, b = u >> 8, tok0 = b * SEQ + ch * 64;
    unsigned char* ws = P.ws;
    const bf16* PROJ = (const bf16*)(ws + WS_PROJ); const bf16* QT = (const bf16*)(ws + WS_QT); const bf16* AM = (const bf16*)(ws + WS_AM); const bf16* VT = (const bf16*)(ws + WS_VT);
    bf16* OB = (bf16*)(ws + WS_OB); const bf16* ST = st_ptr(ws, u);
    LAS bf16* QS = (LAS bf16*)lds;
    LAS bf16* AS = (LAS bf16*)(lds + 33792);
    LAS float* SS = (LAS float*)(lds + 33792 + 9216);
    LAS float* RS = (LAS float*)(lds + 33792 + 9216 + 2048);
#pragma unroll
    for (int it = 0; it < 4; ++it) { const int idx = it * NTHREADS + tid, t = idx >> 5, cc = idx & 31; *(LAS v4u*)(QS + t * 264 + 8 * cc) = *(const v4u*)(QT + ((size_t)u * 64 + t) * 256 + 8 * cc); }
    { const int t = tid >> 3, cc = tid & 7; *(LAS v4u*)(AS + t * 72 + 8 * cc) = *(const v4u*)(AM + ((size_t)u * 64 + t) * 64 + 8 * cc); }
    LAS bf16* RT = (LAS bf16*)(lds + 49152);
#pragma unroll
    for (int it = 0; it < 8; ++it) { const int idx = it * NTHREADS + tid, t = idx >> 6, cc = idx & 63; const v4u rv = *(const v4u*)(PROJ + (size_t)(tok0 + t) * LD0 + 4096 + 512 * h + 8 * cc);
        LAS v2u* d = (LAS v2u*)(RT + t * 516 + 8 * cc); d[0] = (v2u){rv.x, rv.y}; d[1] = (v2u){rv.z, rv.w}; }
    __syncthreads();
    f32x4 acc[4][4];
#pragma unroll
    for (int m = 0; m < 4; ++m)
#pragma unroll
        for (int j = 0; j < 4; ++j) acc[m][j] = (f32x4){0.f, 0.f, 0.f, 0.f};
    const bf16* stp = ST + ((size_t)(q4 >> 1) * 512 + 64 * wave + fr) * 16 + 8 * (q4 & 1); const bf16* vtp = VT + ((size_t)u * 512 + 64 * wave + fr) * 64 + 8 * q4;
#pragma unroll
    for (int kb = 0; kb < 10; ++kb) { bf16x8 bfr[4], afr[4];
#pragma unroll
        for (int j = 0; j < 4; ++j) bfr[j] = kb < 8 ? __builtin_nontemporal_load((const bf16x8*)(stp + (size_t)(2 * kb) * 8192 + 16 * j * 16)) : *(const bf16x8*)(vtp + (size_t)(16 * j) * 64 + 32 * (kb - 8));
#pragma unroll
        for (int m = 0; m < 4; ++m) afr[m] = kb < 8 ? *(const LAS bf16x8*)(QS + (16 * m + fr) * 264 + 32 * kb + 8 * q4) : *(const LAS bf16x8*)(AS + (16 * m + fr) * 72 + 32 * (kb - 8) + 8 * q4);
#pragma unroll
        for (int m = 0; m < 4; ++m)
#pragma unroll
            for (int j = 0; j < 4; ++j) acc[m][j] = __builtin_amdgcn_mfma_f32_16x16x32_bf16(afr[m], bfr[j], acc[m][j], 0, 0, 0); }
#pragma unroll
    for (int m = 0; m < 4; ++m)
#pragma unroll
        for (int i = 0; i < 4; ++i) { float s = 0.f;
#pragma unroll
            for (int j = 0; j < 4; ++j) s += acc[m][j][i] * acc[m][j][i];
            s += __shfl_xor(s, 1); s += __shfl_xor(s, 2); s += __shfl_xor(s, 4); s += __shfl_xor(s, 8);
            if (fr == 0) SS[wave * 64 + 16 * m + 4 * q4 + i] = s; }
    __syncthreads();
    if (tid < 64) { float s = 0.f;
#pragma unroll
        for (int w = 0; w < 8; ++w) s += SS[w * 64 + tid];
        RS[tid] = 1.0f / sqrtf(s * (1.0f / 512.0f) + 1e-6f); }
    __syncthreads();
    const float* ogn = (const float*)(ws + WS_OGAIN); float gn[4];
#pragma unroll
    for (int j = 0; j < 4; ++j) gn[j] = ogn[64 * wave + 16 * j + fr];
#pragma unroll
    for (int m = 0; m < 4; ++m) { const f32x4 rs4 = *(const LAS f32x4*)(RS + 16 * m + 4 * q4);
#pragma unroll
        for (int i = 0; i < 4; ++i) { const int t = 16 * m + 4 * q4 + i; LAS bf16* rp = RT + t * 516 + 64 * wave + fr;
#pragma unroll
            for (int j = 0; j < 4; ++j) { const float r = bf2f(rp[16 * j]); rp[16 * j] = (bf16)f2bf(acc[m][j][i] * rs4[i] * gn[j] * (r / (1.0f + __expf(-r)))); } }
        SBAR(); }
    __syncthreads();
#pragma unroll
    for (int it = 0; it < 16; ++it) { const int idx = it * NTHREADS + tid, t = idx >> 7, cc = idx & 127; *(v2u*)(OB + (size_t)(tok0 + t) * DM + 512 * h + 4 * cc) = *(const LAS v2u*)(RT + t * 516 + 4 * cc); }
    __syncthreads();
}
constexpr float LOG2E = 1.4426950408889634f;
__device__ __forceinline__ void fox_prep(const Params& P, LAS unsigned char* lds) {
    const int tid = opaque_tid(), lane = tid & 63, wave = tid >> 6;
    unsigned char* ws = P.ws;
    const float* qgn = (const float*)(ws + WS_QGAIN); const float* kgn = (const float*)(ws + WS_KGAIN);
    const float qs = 0.08838834764831845f * LOG2E;
    if (blockIdx.x == 0 && wave == 0) { float mq = 0.f, mk = 0.f;
        for (int i = lane; i < 128; i += 64) { mq = fmaxf(mq, fabsf(qgn[i])); mk = fmaxf(mk, fabsf(kgn[i])); }
#pragma unroll
        for (int o = 1; o < 64; o <<= 1) { mq = fmaxf(mq, __shfl_xor(mq, o)); mk = fmaxf(mk, __shfl_xor(mk, o)); }
        if (lane == 0) *(float*)(ws + WS_THR) = 2.0f * (128.0f * mq * mk * qs * 1.05f) + 130.0f; }
    const float* FLR = (const float*)(ws + WS_GLR); float* CF = (float*)(ws + WS_CF);
    for (int sq = blockIdx.x; sq < 32; sq += gridDim.x) { const int b = sq >> 4, h = sq & 15; const float bf = ((const float*)(ws + WS_BF))[h];
        float v[8]; float cum = 0.f;
#pragma unroll
        for (int i = 0; i < 8; ++i) v[i] = FLR[(size_t)(b * SEQ + tid * 8 + i) * 16 + h];
#pragma unroll
        for (int i = 0; i < 8; ++i) { const float z = v[i] + bf; cum += fminf(z, 0.f) - log1pf(expf(-fabsf(z))); v[i] = cum; }
        float incl = cum;
#pragma unroll
        for (int o = 1; o < 64; o <<= 1) { const float t = __shfl_up(incl, o); if (lane >= o) incl += t; }
        LAS float* wt = (LAS float*)lds;
        if (lane == 63) wt[wave] = incl;
        __syncthreads();
        float woff = 0.f;
#pragma unroll
        for (int w = 0; w < 8; ++w) woff += (w < wave) ? wt[w] : 0.f;
        const float excl = woff + incl - cum;
        f32x4 o0, o1;
#pragma unroll
        for (int i = 0; i < 4; ++i) { o0[i] = (v[i] + excl) * LOG2E; o1[i] = (v[4 + i] + excl) * LOG2E; }
        f32x4* dst = (f32x4*)(CF + (size_t)sq * SEQ + tid * 8); dst[0] = o0; dst[1] = o1;
        __syncthreads();
    }
}
#define KSWZ(row, colB) ((row) * 256 + ((colB) ^ (((row) & 7) << 4)))
constexpr int SHM_K = 16384, SHM_V = 16384;
__device__ __forceinline__ int v_st(int k, int c) { const int kk = (k & ~0xC) | ((k & 4) << 1) | ((k & 8) >> 1); return ((kk >> 3) * 4 + (c >> 5)) * 512 + ((kk & 7) * 32 + (c & 31)) * 2; }
__device__ __forceinline__ int v_rd_base(int lane) { return ((lane & 3) << 3) | (((lane >> 2) & 3) << 6) | (((lane >> 4) & 1) << 5) | (((lane >> 5) & 1) << 8); }
constexpr int v_rd_off(int d0, int ks, int half) { return d0 * 512 + ks * 4096 + half * 2048; }
__device__ __forceinline__ int crow(int r, int hi) { return (r & 3) + 8 * (r >> 2) + 4 * hi; }
template <int KB>
__device__ __forceinline__ void qkt(f32x16& p0, f32x16& p1, const char* K_lds, int r32, int hi, const bf16x8* qs) {
    p0 = f32x16{}; p1 = f32x16{};
    const char* kb[4];
#pragma unroll
    for (int dd = 0; dd < 4; ++dd) kb[dd] = K_lds + KB * SHM_K + KSWZ(r32, (dd * 16 + hi * 8) * 2);
#pragma unroll
    for (int d0 = 0; d0 < 8; ++d0) { const char* a = kb[d0 & 3] + (d0 >> 2) * 128;
        bf16x8 b0 = *reinterpret_cast<const bf16x8*>(a);
        bf16x8 b1 = *reinterpret_cast<const bf16x8*>(a + 32 * 256);
        const bf16x8 qf = qs[d0 * 64];
        p0 = __builtin_amdgcn_mfma_f32_32x32x16_bf16(b0, qf, p0, 0, 0, 0);
        p1 = __builtin_amdgcn_mfma_f32_32x32x16_bf16(b1, qf, p1, 0, 0, 0); }
}
template <int VB>
__device__ __forceinline__ void pv_tile(f32x16* o, int vb0, bf16x8 pa0, bf16x8 pa1, bf16x8 pa2, bf16x8 pa3) {
#define TRRD(dst, off) asm volatile("ds_read_b64_tr_b16 %0, %1 offset:%2" : "=&v"(dst) : "v"(vb0), "i"(off) : "memory")
#define PV_RD(S, d0) do { constexpr int b_ = VB * SHM_V + v_rd_off(d0, 0, 0); \
        TRRD(S##l0, b_); TRRD(S##h0, b_ + 2048); TRRD(S##l1, b_ + 4096); TRRD(S##h1, b_ + 6144); TRRD(S##l2, b_ + 8192); TRRD(S##h2, b_ + 10240); TRRD(S##l3, b_ + 12288); TRRD(S##h3, b_ + 14336); } while (0)
#define PV_WAIT(n) do { asm volatile("s_waitcnt lgkmcnt(%0)" :: "i"(n) : "memory"); SBAR(); } while (0)
#define PV_MM(S, d0) do { \
        o[d0] = __builtin_amdgcn_mfma_f32_32x32x16_bf16(pa0, (bf16x8){S##l0[0], S##l0[1], S##l0[2], S##l0[3], S##h0[0], S##h0[1], S##h0[2], S##h0[3]}, o[d0], 0, 0, 0); \
        o[d0] = __builtin_amdgcn_mfma_f32_32x32x16_bf16(pa1, (bf16x8){S##l1[0], S##l1[1], S##l1[2], S##l1[3], S##h1[0], S##h1[1], S##h1[2], S##h1[3]}, o[d0], 0, 0, 0); \
        o[d0] = __builtin_amdgcn_mfma_f32_32x32x16_bf16(pa2, (bf16x8){S##l2[0], S##l2[1], S##l2[2], S##l2[3], S##h2[0], S##h2[1], S##h2[2], S##h2[3]}, o[d0], 0, 0, 0); \
        o[d0] = __builtin_amdgcn_mfma_f32_32x32x16_bf16(pa3, (bf16x8){S##l3[0], S##l3[1], S##l3[2], S##l3[3], S##h3[0], S##h3[1], S##h3[2], S##h3[3]}, o[d0], 0, 0, 0); SBAR(); } while (0)
    s16x4 Al0, Al1, Al2, Al3, Ah0, Ah1, Ah2, Ah3, Bl0, Bl1, Bl2, Bl3, Bh0, Bh1, Bh2, Bh3;
    PV_RD(A, 0); PV_RD(B, 1); PV_WAIT(8); PV_MM(A, 0);
    PV_RD(A, 2); PV_WAIT(8); PV_MM(B, 1);
    PV_RD(B, 3); PV_WAIT(8); PV_MM(A, 2);
    PV_WAIT(0); PV_MM(B, 3);
#undef PV_RD
#undef PV_WAIT
#undef PV_MM
#undef TRRD
}
__device__ __forceinline__ bf16x8 knorm8(bf16x8 x, const float* g) {
    const v4u xv = __builtin_bit_cast(v4u, x); float f[8];
#pragma unroll
    for (int e = 0; e < 4; ++e) { f[2 * e] = __builtin_bit_cast(float, xv[e] << 16); f[2 * e + 1] = __builtin_bit_cast(float, xv[e] & 0xffff0000u); }
    float s = 0.f;
#pragma unroll
    for (int e = 0; e < 8; ++e) s += f[e] * f[e];
    s += __shfl_xor(s, 1); s += __shfl_xor(s, 2); s += __shfl_xor(s, 4); s += __shfl_xor(s, 8);
    const float r = 1.0f / sqrtf(s * (1.0f / 128.0f) + 1e-6f);
    const f32x4 g0 = *(const f32x4*)g, g1 = *(const f32x4*)(g + 4);
    v4u w; w.x = cvtpk(f[0] * r * g0[0], f[1] * r * g0[1]); w.y = cvtpk(f[2] * r * g0[2], f[3] * r * g0[3]); w.z = cvtpk(f[4] * r * g1[0], f[5] * r * g1[1]); w.w = cvtpk(f[6] * r * g1[2], f[7] * r * g1[3]);
    return __builtin_bit_cast(bf16x8, w);
}
template <int BUF>
__device__ __forceinline__ void fox_tile(f32x16* o, float& m_reg, float& l_reg, const char* lds, const float* ckl, float* al_l, int vb0, const bf16x8* qr, float cq, int qpos, int kb0, bool need_mask, int r32, int hi) {
    f32x16 p0, p1;
    qkt<BUF>(p0, p1, lds + 2 * SHM_V, r32, hi, qr);
    const float* ck = ckl + kb0 + 4 * hi;
#pragma unroll
    for (int g = 0; g < 4; ++g) { const f32x4 c0 = *(const f32x4*)(ck + 8 * g), c1 = *(const f32x4*)(ck + 32 + 8 * g);
#pragma unroll
        for (int e = 0; e < 4; ++e) { p0[4 * g + e] += cq - c0[e]; p1[4 * g + e] += cq - c1[e]; } }
    if (need_mask) { const float NEG = -__builtin_inff(); const int dq = qpos - kb0 - 4 * hi;
#pragma unroll
        for (int r = 0; r < 16; ++r) { const int c = (r & 3) + 8 * (r >> 2); if (c > dq) p0[r] = NEG; if (c + 32 > dq) p1[r] = NEG; } }
    float pmax = p0[0];
#pragma unroll
    for (int r = 1; r < 16; ++r) pmax = fmaxf(pmax, p0[r]);
#pragma unroll
    for (int r = 0; r < 16; ++r) pmax = fmaxf(pmax, p1[r]);
    { auto rr = __builtin_amdgcn_permlane32_swap(__float_as_uint(pmax), __float_as_uint(pmax), false, false); pmax = fmaxf(__uint_as_float(rr[0]), __uint_as_float(rr[1])); }
    const float mn = fmaxf(m_reg, pmax), alpha = __builtin_amdgcn_exp2f(m_reg - mn); m_reg = mn;
    float ps = 0.f;
#pragma unroll
    for (int r = 0; r < 16; ++r) { p0[r] = __builtin_amdgcn_exp2f(p0[r] - mn); p1[r] = __builtin_amdgcn_exp2f(p1[r] - mn); ps += p0[r] + p1[r]; }
    { auto rr = __builtin_amdgcn_permlane32_swap(__float_as_uint(ps), __float_as_uint(ps), false, false); ps = __uint_as_float(rr[0]) + __uint_as_float(rr[1]); }
    l_reg = l_reg * alpha + ps;
    bf16x8 pa0, pa1, pa2, pa3;
#define PK4(Pv, B_, OUT) do { unsigned a0 = cvtpk(Pv[B_+0], Pv[B_+1]), a1 = cvtpk(Pv[B_+2], Pv[B_+3]); unsigned b0 = cvtpk(Pv[B_+4], Pv[B_+5]), b1 = cvtpk(Pv[B_+6], Pv[B_+7]); \
        auto r0 = __builtin_amdgcn_permlane32_swap(a0, b0, false, false); auto r1 = __builtin_amdgcn_permlane32_swap(a1, b1, false, false); \
        v4u w = {r0[0], r1[0], r0[1], r1[1]}; OUT = __builtin_bit_cast(bf16x8, w); } while (0)
    PK4(p0, 0, pa0); PK4(p0, 8, pa1); PK4(p1, 0, pa2); PK4(p1, 8, pa3);
#undef PK4
    if (__any(alpha < 1.f)) { if (hi == 0) al_l[r32] = alpha; asm volatile("s_waitcnt lgkmcnt(0)" ::: "memory");
#pragma unroll
        for (int d_ = 0; d_ < 4; ++d_)
#pragma unroll
            for (int r = 0; r < 16; ++r) o[d_][r] *= al_l[crow(r, hi)]; }
    SBAR();
    pv_tile<BUF>(o, vb0, pa0, pa1, pa2, pa3);
}
__device__ __forceinline__ void fox_attn_unit(const Params& P, char* lds, int b, int h, int qb) {
    const int tid = opaque_tid(), wid = __builtin_amdgcn_readfirstlane(tid >> 6), lane = tid & 63, r32 = lane & 31, hi = lane >> 5;
    unsigned char* ws = P.ws; const bf16* PROJ = (const bf16*)(ws + WS_PROJ); const float* CF = (const float*)(ws + WS_CF) + (size_t)(b * 16 + h) * SEQ; bf16* OB = (bf16*)(ws + WS_OB);
    char* V_lds = lds; char* K_lds = lds + 2 * SHM_V;
    float* ckl = (float*)(lds + 2 * SHM_V + 2 * SHM_K);
    float* al_l = (float*)(lds + 2 * SHM_V + 2 * SHM_K + 16384) + wid * 64;
    const int q0 = qb * 256, qlo = q0 + wid * 32, qpos = qlo + r32;
    const bf16* Qp = PROJ + (size_t)(b * SEQ + qpos) * LD1 + h * 128 + hi * 8;
    const bf16* Kh = PROJ + (size_t)(b * SEQ) * LD1 + 2048 + h * 128; const bf16* Vh = Kh + 2048;
    bf16x8* qr = (bf16x8*)(lds + 83968 + wid * 8192) + lane;
    float* kgl = (float*)(lds + 149504);
    if (tid < 32) ((f32x4*)kgl)[tid] = ((const f32x4*)(ws + WS_KGAIN))[tid];
    {
      v4u qv[8]; float ssq = 0.f;
#pragma unroll
      for (int d0 = 0; d0 < 8; ++d0) { qv[d0] = *(const v4u*)(Qp + d0 * 16);
#pragma unroll
          for (int e = 0; e < 4; ++e) { const float a = __builtin_bit_cast(float, qv[d0][e] << 16), c = __builtin_bit_cast(float, qv[d0][e] & 0xffff0000u); ssq += a * a + c * c; } }
      ssq += __shfl_xor(ssq, 32);
      const float rq = (0.08838834764831845f * LOG2E) / sqrtf(ssq * (1.0f / 128.0f) + 1e-6f); const float* qgn = (const float*)(ws + WS_QGAIN) + hi * 8;
#pragma unroll
      for (int d0 = 0; d0 < 8; ++d0) { const f32x4 g0 = *(const f32x4*)(qgn + d0 * 16), g1 = *(const f32x4*)(qgn + d0 * 16 + 4); v4u w;
#pragma unroll
          for (int e = 0; e < 4; ++e) { const float a = __builtin_bit_cast(float, qv[d0][e] << 16), c = __builtin_bit_cast(float, qv[d0][e] & 0xffff0000u); const float ga = e < 2 ? g0[2 * e] : g1[2 * e - 4], gc = e < 2 ? g0[2 * e + 1] : g1[2 * e - 3];
              w[e] = cvtpk(a * rq * ga, c * rq * gc); }
          qr[d0 * 64] = __builtin_bit_cast(bf16x8, w); } }
    const float cq = CF[qpos];
    const int sr = tid >> 4, sc = (tid & 15) * 8, vst0 = v_st(sr, sc), vst1 = v_st(32 + sr, sc), kws = KSWZ(sr, sc * 2);
    const int vb0 = (int)(uintptr_t)V_lds + v_rd_base(lane);
    const int NT = 4 * (qb + 1);
    bf16x8 st_k0, st_k1, st_v0, st_v1;
    for (int i = tid; i < (q0 + 256) / 4; i += NTHREADS) ((f32x4*)ckl)[i] = ((const f32x4*)CF)[i];
#define SLOAD(t) do { const size_t r0_ = (size_t)((t) * 64 + sr) * LD1 + sc; st_k0 = *(const bf16x8*)(Kh + r0_); st_k1 = *(const bf16x8*)(Kh + r0_ + (size_t)32 * LD1); \
        st_v0 = *(const bf16x8*)(Vh + r0_); st_v1 = *(const bf16x8*)(Vh + r0_ + (size_t)32 * LD1); } while (0)
#define SWRITE(bf) do { *(bf16x8*)(K_lds + (bf) * SHM_K + kws) = knorm8(st_k0, kgl + sc); *(bf16x8*)(K_lds + (bf) * SHM_K + kws + 32 * 256) = knorm8(st_k1, kgl + sc); \
        *(bf16x8*)(V_lds + (bf) * SHM_V + vst0) = st_v0; *(bf16x8*)(V_lds + (bf) * SHM_V + vst1) = st_v1; } while (0)
    float m_reg = -1e30f, l_reg = 0.f; f32x16 o[4] = {};
    __syncthreads();
    int j_lo; { const float thr = *(const float*)(ws + WS_THR), cq0 = ckl[q0];
        const bool skip = lane < 4 * qb && ckl[64 * lane + 63] - cq0 > thr; const unsigned long long bm = __ballot(!skip); j_lo = (int)__builtin_ctzll(bm) & ~1; }
    SLOAD(NT - 1); SWRITE(0);
    __syncthreads();
    for (int t = NT - 1; t > j_lo; t -= 2) {
        SLOAD(t - 1);
        { const int kb0 = t * 64; fox_tile<0>(o, m_reg, l_reg, lds, ckl, al_l, vb0, qr, cq, qpos, kb0, kb0 + 63 > qlo, r32, hi); }
        SWRITE(1);
        __syncthreads();
        if (t - 2 > j_lo) SLOAD(t - 2);
        { const int kb0 = (t - 1) * 64; fox_tile<1>(o, m_reg, l_reg, lds, ckl, al_l, vb0, qr, cq, qpos, kb0, kb0 + 63 > qlo, r32, hi); }
        if (t - 2 > j_lo) SWRITE(0);
        __syncthreads();
    }
#undef SLOAD
#undef SWRITE
    if (hi == 0) al_l[r32] = l_reg; asm volatile("s_waitcnt lgkmcnt(0)" ::: "memory");
    bf16* stg = (bf16*)(lds + wid * 8192);
#pragma unroll
    for (int r = 0; r < 16; ++r) { const int row = crow(r, hi); const float rl = 1.0f / al_l[row];
#pragma unroll
        for (int d_ = 0; d_ < 4; ++d_) stg[row * 128 + d_ * 32 + r32] = (bf16)f2bf(o[d_][r] * rl); }
    asm volatile("s_waitcnt lgkmcnt(0)" ::: "memory");
    { const int ch = lane & 15; const bf16* ogp = PROJ + (size_t)(b * SEQ + qlo) * LD1 + 6144 + h * 128 + ch * 8; bf16* op = OB + (size_t)(b * SEQ + qlo) * DM + h * 128 + ch * 8;
#pragma unroll 2
      for (int i = 0; i < 8; ++i) { const int row = i * 4 + (lane >> 4); const v4u ov = *(const v4u*)(stg + row * 128 + ch * 8); const v4u gv = *(const v4u*)(ogp + (size_t)row * LD1); v4u w;
#pragma unroll
          for (int e = 0; e < 4; ++e) { const float o0 = __builtin_bit_cast(float, ov[e] << 16), o1 = __builtin_bit_cast(float, ov[e] & 0xffff0000u), g0 = __builtin_bit_cast(float, gv[e] << 16), g1 = __builtin_bit_cast(float, gv[e] & 0xffff0000u);
              w[e] = pk2(o0 / (1.0f + __expf(-g0)), o1 / (1.0f + __expf(-g1))); }
          *(v4u*)(op + (size_t)row * DM) = w; } }
    __syncthreads();
}
#define RLX_AGENT __ATOMIC_RELAXED, __HIP_MEMORY_SCOPE_AGENT
#define XB_TMO      128
#define XB_XCNT(j)  (256  + 64 * (j))
#define XB_XSUB(j)  (1280 + 64 * (j))
#define XB_XGEN(j)  (2304 + 64 * (j))
#define XB_TOP      3328
#define XB_TOPGEN   3392
#define XCD_BAR_WORDS 3456
#define XB_SPIN_CAP (1u << 18)

__device__ __forceinline__ unsigned xb_ld(unsigned* p)              { return __hip_atomic_load(p, __ATOMIC_RELAXED, __HIP_MEMORY_SCOPE_AGENT); }
__device__ __forceinline__ unsigned xb_add(unsigned* p, unsigned v) { return __hip_atomic_fetch_add(p, v, __ATOMIC_RELAXED, __HIP_MEMORY_SCOPE_AGENT); }
__device__ __forceinline__ unsigned xb_xcc_id() { return (unsigned)__builtin_amdgcn_s_getreg((3 << 11) | 20) & 0xFu; }
#define XB_SPIN(cond, bar) do { unsigned _sp = 0; while (cond) { __builtin_amdgcn_s_sleep(1); \
    if ((++_sp & 255u) == 0u) { if (xb_ld(&(bar)[XB_TMO])) break; if (_sp > XB_SPIN_CAP) { atomicAdd(&(bar)[XB_TMO], 1u); break; } } } } while (0)

struct XcdBarrier {
    unsigned* bar; unsigned x;
    volatile LAS unsigned* st;
};

__device__ __forceinline__ XcdBarrier xcd_barrier_post(unsigned* bar, volatile LAS unsigned* st) {
    XcdBarrier b; b.bar = bar; b.x = xb_xcc_id(); b.st = st;
    if (threadIdx.x == 0) (void)xb_add(&bar[XB_XCNT(b.x)], 1u);
    return b;
}
__device__ __forceinline__ void xcd_barrier_complete(unsigned* bar, unsigned x, unsigned& nloc, unsigned& nx) {
    const unsigned G = gridDim.x * gridDim.y * gridDim.z;
    unsigned sum, cnt, mine, sp = 0u;
    for (;;) {
        sum = 0u; cnt = 0u; mine = 0u;
#pragma unroll
        for (unsigned j = 0; j < 16; ++j) { const unsigned c = xb_ld(&bar[XB_XCNT(j)]); sum += c; cnt += (c > 0u) ? 1u : 0u; mine = (j == x) ? c : mine; }
        if (sum == G) break;
        __builtin_amdgcn_s_sleep(1);
        if ((++sp & 255u) == 0u) { if (xb_ld(&bar[XB_TMO])) break; if (sp > XB_SPIN_CAP) { atomicAdd(&bar[XB_TMO], 1u); break; } }
    }
    nloc = mine > 0u ? mine : 1u; nx = cnt > 0u ? cnt : 1u;
}

__device__ __forceinline__ void xcd_barrier(const XcdBarrier& b) {
    asm volatile("s_waitcnt vmcnt(0)" ::: "memory");
    __syncthreads();
    if (threadIdx.x == 0) {
        unsigned* bar = b.bar;
        __builtin_amdgcn_s_waitcnt(0);
        unsigned nloc = b.st[0], nx = b.st[1];
        if (nloc == 0u) { xcd_barrier_complete(bar, b.x, nloc, nx); b.st[0] = nloc; b.st[1] = nx; }
        const unsigned old = xb_add(&bar[XB_XSUB(b.x)], 1u);
        const unsigned gen = old / nloc;
        if (old + 1u == (gen + 1u) * nloc) {
            __builtin_amdgcn_fence(__ATOMIC_RELEASE, "agent");
            asm volatile("s_waitcnt vmcnt(0)" ::: "memory");
            const unsigned og = xb_add(&bar[XB_TOP], 1u);
            const unsigned tg = og / nx;
            if (og + 1u == (tg + 1u) * nx) xb_add(&bar[XB_TOPGEN], 1u);
            else XB_SPIN(xb_ld(&bar[XB_TOPGEN]) == tg, bar);
            __builtin_amdgcn_fence(__ATOMIC_ACQUIRE, "agent");
            xb_add(&bar[XB_XGEN(b.x)], 1u);
            asm volatile("s_waitcnt vmcnt(0)" ::: "memory");
        } else {
            XB_SPIN(xb_ld(&bar[XB_XGEN(b.x)]) == gen, bar);
            __builtin_amdgcn_fence(__ATOMIC_ACQUIRE, "agent");
            asm volatile("s_waitcnt vmcnt(0)" ::: "memory");
        }
    }
    __syncthreads();
}
constexpr int N_PHASES = 14;
#ifndef MK_MULTI
#define MK_MULTI 0
#endif
__global__ void __launch_bounds__(NTHREADS, 2) hybrid_fwd(Params P) {
    extern __shared__ __attribute__((aligned(16))) unsigned char lds_raw[];
    LAS unsigned char* lds = (LAS unsigned char*)lds_raw;
    cg::grid_group grid = cg::this_grid();
    unsigned char* ws = P.ws;
    volatile LAS unsigned* bst = (volatile LAS unsigned*)(lds + LDS_BYTES - 64);
    if (threadIdx.x == 0) { bst[0] = 0u; bst[1] = 0u; }
    __syncthreads();
    XcdBarrier xbar = xcd_barrier_post((unsigned*)(ws + WS_BAR), bst);
    const int vcu = (gridDim.x % 8 == 0) ? (int)((blockIdx.x % 8) * (gridDim.x / 8) + blockIdx.x / 8) : (int)blockIdx.x;
#if MK_MULTI
    const int lo = P.ph_lo, hi = P.ph_hi;
#else
    constexpr int lo = 0, hi = 14;
#endif
    bf16* XB = (bf16*)(ws + WS_XB); bf16* OB = (bf16*)(ws + WS_OB); bf16* PROJ = (bf16*)(ws + WS_PROJ); float* SSQ = (float*)(ws + WS_SSQ); float* GLR = (float*)(ws + WS_GLR);
#ifndef PHM
#define PHM 0x3fff
#endif
#define IN(k) ((((PHM) >> (k)) & 1) && lo <= (k) && (k) < hi)
#ifndef DUP
#define DUP -1
#endif
#define SEAM(k) do { if (IN(k) && IN((k) + 1)) xcd_barrier(xbar); } while (0)
    if (P.ph_hi < 0) grid.sync();
    for (int rep_ = 0; rep_ < (DUP == 0 ? 2 : 1); ++rep_)
    if (IN(0)) { p0_prologue(P, lds, 0, blockIdx.x, gridDim.x); } SEAM(0);
    if (IN(1)) {
        pg8::Gemm g{XB, (const bf16*)(ws + WS_WGI), M, 6144, DM}; pg8::StaticOrder S; S.init(M, 6144, gridDim.x, blockIdx.x);
        PG8_LAS float* rst = (PG8_LAS float*)(lds + 131072); pg8::fill_rstd_table(rst, SSQ, S);
        pg8::EpiScaleBf16 E{PROJ, LD0, rst};
        pg8::gemm_phase<pg8::EpiScaleBf16, pg8::StaticOrder, true, true>(lds, g, S, E);
        thin_gemm(XB, (const bf16*)(ws + WS_W1T), SSQ, GLR, lds);
    } SEAM(1);
    for (int rep_ = 0; rep_ < (DUP == 2 ? 2 : 1); ++rep_)
    if (IN(2)) { for (int u = blockIdx.x; u < 512; u += gridDim.x) gla_prep_unit(P, lds, u); } SEAM(2);
    for (int rep_ = 0; rep_ < (DUP == 3 ? 2 : 1); ++rep_)
    if (IN(3)) { for (int u = blockIdx.x; u < 256; u += gridDim.x) gla_scan_unit(P, lds, u); } SEAM(3);
    for (int rep_ = 0; rep_ < (DUP == 4 ? 2 : 1); ++rep_)
    if (IN(4)) { for (int u = blockIdx.x; u < 512; u += gridDim.x) gla_out_unit(P, lds, u); } SEAM(4);
#ifdef SYNCX
    for (int rep_ = 0; rep_ < SYNCX; ++rep_) xcd_barrier(xbar);
#endif
    for (int rep_ = 0; rep_ < (DUP == 5 ? 2 : 1); ++rep_)
    if (IN(5)) {
        pg8::Gemm g{OB, (const bf16*)(ws + WS_WGO), M, DM, DM}; pg8::StaticOrder S; S.init(M, DM, gridDim.x, blockIdx.x);
        pg8::EpiResid<0> E{P.x, P.out, XB, SSQ};
        pg8::gemm_phase<pg8::EpiResid<0>, pg8::StaticOrder, true, true>(lds, g, S, E);
    } SEAM(5);
    for (int rep_ = 0; rep_ < (DUP == 6 ? 2 : 1); ++rep_)
    if (IN(6)) {
        const int ngemm = (gridDim.x == 256 && DUP != 6) ? 235 : (int)gridDim.x;
        if ((int)blockIdx.x < ngemm) {
        pg8::Gemm g{XB, (const bf16*)(ws + WS_WGU0), M, 2 * DFF, DM}; pg8::StaticOrder S; S.init(M, 2 * DFF, ngemm, blockIdx.x);
        PG8_LAS float* rst = (PG8_LAS float*)(lds + 131072); pg8::fill_rstd_table(rst, SSQ, S);
        pg8::EpiSwiGLU E{PROJ, DFF, rst};
        pg8::gemm_phase<pg8::EpiSwiGLU, pg8::StaticOrder, true, true>(lds, g, S, E);
        if (ngemm == (int)gridDim.x && rep_ == 0) p0_prologue(P, lds, 1, blockIdx.x, gridDim.x);
        } else p0_prologue(P, lds, 1, blockIdx.x - ngemm, gridDim.x - ngemm);
    } SEAM(6);
    if (IN(7)) {
        pg8::Gemm g{PROJ, (const bf16*)(ws + WS_WD0), M, DM, DFF}; pg8::StaticOrder S; S.init(M, DM, gridDim.x, blockIdx.x);
        pg8::EpiResid<1> E{nullptr, P.out, XB, SSQ};
        pg8::gemm_phase<pg8::EpiResid<1>, pg8::StaticOrder, true, true>(lds, g, S, E);
    } SEAM(7);
    if (IN(8)) {
        pg8::Gemm g{XB, (const bf16*)(ws + WS_WFI), M, 8192, DM}; pg8::StaticOrder S; S.init(M, 8192, gridDim.x, blockIdx.x);
        PG8_LAS float* rst = (PG8_LAS float*)(lds + 131072); pg8::fill_rstd_table(rst, SSQ, S);
        pg8::EpiScaleBf16 E{PROJ, LD1, rst};
        pg8::gemm_phase<pg8::EpiScaleBf16, pg8::StaticOrder, true, true>(lds, g, S, E);
        thin_gemm(XB, (const bf16*)(ws + WS_WFT), SSQ, GLR, lds);
    } SEAM(8);
    if (IN(9)) { fox_prep(P, lds); } SEAM(9);
    for (int rep_ = 0; rep_ < (DUP == 10 ? 2 : 1); ++rep_)
    if (IN(10)) {
        for (int pr = vcu; pr < 256; pr += gridDim.x) { const int bh = pr >> 3, s = pr & 7;
            fox_attn_unit(P, (char*)lds_raw, bh >> 4, bh & 15, 15 - s); fox_attn_unit(P, (char*)lds_raw, bh >> 4, bh & 15, s); }
    } SEAM(10);
    if (IN(11)) {
        pg8::Gemm g{OB, (const bf16*)(ws + WS_WFO), M, DM, DM}; pg8::StaticOrder S; S.init(M, DM, gridDim.x, blockIdx.x);
        pg8::EpiResid<1> E{nullptr, P.out, XB, SSQ};
        pg8::gemm_phase<pg8::EpiResid<1>, pg8::StaticOrder, true, true>(lds, g, S, E);
    } SEAM(11);
    if (IN(12)) {
        const int ngemm = gridDim.x == 256 ? 235 : (int)gridDim.x;
        if ((int)blockIdx.x < ngemm) {
        pg8::Gemm g{XB, (const bf16*)(ws + WS_WGU1), M, 2 * DFF, DM}; pg8::StaticOrder S; S.init(M, 2 * DFF, ngemm, blockIdx.x);
        PG8_LAS float* rst = (PG8_LAS float*)(lds + 131072); pg8::fill_rstd_table(rst, SSQ, S);
        pg8::EpiSwiGLU E{PROJ, DFF, rst};
        pg8::gemm_phase<pg8::EpiSwiGLU, pg8::StaticOrder, true, true>(lds, g, S, E);
        if (ngemm == (int)gridDim.x) p0_prologue(P, lds, 2, blockIdx.x, gridDim.x);
        } else p0_prologue(P, lds, 2, blockIdx.x - ngemm, gridDim.x - ngemm);
    } SEAM(12);
    if (IN(13)) {
        pg8::Gemm g{PROJ, (const bf16*)(ws + WS_WD1), M, DM, DFF}; pg8::StaticOrder S; S.init(M, DM, gridDim.x, blockIdx.x);
        pg8::EpiResid<2> E{nullptr, P.out, XB, SSQ};
        pg8::gemm_phase<pg8::EpiResid<2>, pg8::StaticOrder, true, true>(lds, g, S, E);
    }
#undef IN
#undef SEAM
}

extern "C" void kernel_launch(void* const* d_in, const int* in_sizes, int n_in, void* d_out, int out_size, void* d_ws, size_t ws_size, hipStream_t stream) {
    static int grid = 0;
    if (grid == 0) {
        if (n_in != 16 || in_sizes[0] != M * DM || out_size != M * DM || ws_size < WS_END) { fprintf(stderr, "kernel_launch: unexpected shapes/workspace (n_in %d, ws %zu, need %zu)\n", n_in, ws_size, (size_t)WS_END); grid = -1; return; }
        int dev = 0, cus = 0, per_cu = 0;
        hipGetDevice(&dev); hipDeviceGetAttribute(&cus, hipDeviceAttributeMultiprocessorCount, dev);
        if (hipFuncSetAttribute((const void*)hybrid_fwd, hipFuncAttributeMaxDynamicSharedMemorySize, LDS_BYTES) != hipSuccess) { fprintf(stderr, "kernel_launch: hipFuncSetAttribute failed\n"); grid = -1; return; }
        if (hipOccupancyMaxActiveBlocksPerMultiprocessor(&per_cu, (const void*)hybrid_fwd, NTHREADS, LDS_BYTES) != hipSuccess || per_cu < 1) { fprintf(stderr, "kernel_launch: occupancy query gives %d\n", per_cu); per_cu = 1; (void)hipGetLastError(); }
        grid = cus * per_cu;
        fprintf(stderr, "kernel_launch: grid %d (%d CUs x %d)\n", grid, cus, per_cu);
    }
    if (grid < 0) return;
    if (hipMemsetAsync((char*)d_ws + WS_BAR, 0, 16384, stream) != hipSuccess) { fprintf(stderr, "kernel_launch: memset failed\n"); return; }
    Params p{};
    const float* const* in = (const float* const*)d_in;
    p.x = in[0]; p.norm_mix = in[1]; p.norm_ffn = in[2]; p.gla_w_in = in[3]; p.gla_w_g2 = in[4]; p.gla_b_g2 = in[5]; p.gla_o_gain = in[6]; p.gla_w_o = in[7];
    p.fox_w_in = in[8]; p.fox_b_f = in[9]; p.fox_q_gain = in[10]; p.fox_k_gain = in[11]; p.fox_w_o = in[12]; p.ffn_w_gate = in[13]; p.ffn_w_up = in[14]; p.ffn_w_down = in[15];
    p.out = (float*)d_out; p.ws = (unsigned char*)d_ws;
#if MK_MULTI
    for (int ph = 0; ph < N_PHASES; ++ph) { p.ph_lo = ph; p.ph_hi = ph + 1; hipLaunchKernelGGL(hybrid_fwd, dim3(grid), dim3(NTHREADS), LDS_BYTES, stream, p); }
#else
    p.ph_lo = 0; p.ph_hi = N_PHASES;
    void* args[] = {&p};
    hipError_t e = hipLaunchCooperativeKernel((const void*)hybrid_fwd, dim3(grid), dim3(NTHREADS), args, LDS_BYTES, stream);
    if (e != hipSuccess) fprintf(stderr, "cooperative launch failed: %s (grid %d)\n", hipGetErrorString(e), grid);
#endif
}
```

```cpp
#include <hip/hip_runtime.h>
#include <hip/hip_cooperative_groups.h>
#include <cstdio>
#include <cstdint>
namespace cg = cooperative_groups;
__device__ __forceinline__ int opaque_tid() { int t = threadIdx.x; asm volatile("" : "+v"(t)); return t; }
typedef float f32x2_t __attribute__((ext_vector_type(2))); typedef __bf16 bf16x2_t __attribute__((ext_vector_type(2)));
__device__ __forceinline__ unsigned cvtpk(float lo, float hi) { f32x2_t v = {lo, hi}; bf16x2_t b = __builtin_convertvector(v, bf16x2_t); return __builtin_bit_cast(unsigned, b); }
namespace pg8 {
#define PG8_LAS __attribute__((address_space(3)))
typedef unsigned short bf16_t;
typedef short bf16x8 __attribute__((ext_vector_type(8)));
typedef float f32x4 __attribute__((ext_vector_type(4)));
typedef unsigned u32x4 __attribute__((ext_vector_type(4)));
constexpr int BM = 256, BK = 64, HALF = 128, HTB = HALF * BK * 2  , STAGE_BYTES = 8 * HTB, NXCD = 8, WGM = 8;

__host__ __device__ __forceinline__ int lds_byte(int r, int c) { const int st = (r >> 4) * 2 + (c >> 5), rr = r & 15, cc = c & 31, ob = rr * 64 + cc * 2; return st * 1024 + (ob ^ (((ob >> 9) & 1) << 5)); }
__host__ __device__ __forceinline__ void stage_rc(int b, int& R, int& C) { const int st = b / 1024, sb = b % 1024, swz = sb ^ (((sb >> 9) & 1) << 5); R = (st >> 1) * 16 + swz / 64; C = (st & 1) * 32 + (swz % 64) / 2; }
__host__ __device__ __forceinline__ int perm32(int rho) { const int n = rho >> 4, i = rho & 15; return 8 * (i >> 2) + 4 * n + (i & 3); }

struct Unit { int pm, pn; };
struct Gemm { const bf16_t* A; const bf16_t* Bt; int M, N, K; };

struct StaticOrder {
    int nM, nN, nwg, G, c;
    __host__ __device__ void init(int M, int N, int G_, int c_) { nM = M / BM; nN = N / BM; nwg = nM * nN; G = G_; c = c_; }
    __host__ __device__ bool next(int i, Unit& u) const {
        const long L = (long)i * G + c; if (L >= nwg) return false;
        int wgid = (int)L; { const int q = nwg / NXCD, r = nwg % NXCD, xcd = wgid % NXCD, off = wgid / NXCD; wgid = (xcd < r ? xcd * (q + 1) : r * (q + 1) + (xcd - r) * q) + off; }
        const int nig = WGM * nN, gid = wgid / nig, fm = gid * WGM, gsz = (nM - fm) < WGM ? (nM - fm) : WGM;
        u.pm = fm + ((wgid % nig) % gsz); u.pn = (wgid % nig) / gsz; return true;
    }
    __device__ __forceinline__ void a_ready(const Unit&) const {}
    __device__ __forceinline__ void done(const Unit&) const {}
};

typedef unsigned u32x2 __attribute__((ext_vector_type(2)));
__device__ __forceinline__ unsigned cvt_pk_bf16(float lo, float hi) { return ::cvtpk(lo, hi); }
constexpr float RMS_EPS = 1e-6f;
__device__ __forceinline__ void row_rstd(const float* ssq, int row0, int fq, float (&rs)[2][4]) {
#pragma unroll
    for (int ai = 0; ai < 2; ++ai)
#pragma unroll
        for (int m = 0; m < 4; ++m) { const f32x4* p = (const f32x4*)(ssq + (size_t)(row0 + ai * HALF + m * 16) * 32 + fq * 8); const f32x4 a = p[0], b = p[1];
            float s = ((a[0] + a[1]) + (a[2] + a[3])) + ((b[0] + b[1]) + (b[2] + b[3])); s += __shfl_xor(s, 16); s += __shfl_xor(s, 32);
            rs[ai][m] = 1.0f / sqrtf(s * (1.0f / 2048.0f) + RMS_EPS); }
}
__device__ __forceinline__ void rstd_from_table(const PG8_LAS float* t, float (&rs)[2][4]) {
#pragma unroll
    for (int ai = 0; ai < 2; ++ai)
#pragma unroll
        for (int m = 0; m < 4; ++m) rs[ai][m] = t[ai * HALF + m * 16];
}
template <class Sched> __device__ __forceinline__ void fill_rstd_table(PG8_LAS float* tab, const float* ssq, const Sched& S) {
    const int tid = threadIdx.x, r = tid >> 1, hf = tid & 1; Unit u;
    for (int i = 0; S.next(i, u); ++i) { const f32x4* p = (const f32x4*)(ssq + (size_t)(u.pm * BM + r) * 32 + hf * 16); float s = 0.f;
#pragma unroll
        for (int j = 0; j < 4; ++j) { const f32x4 a = p[j]; s += (a[0] + a[1]) + (a[2] + a[3]); }
        s += __shfl_xor(s, 1);
        if (hf == 0) tab[i * 256 + r] = 1.0f / sqrtf(s * (1.0f / 2048.0f) + RMS_EPS); }
    __syncthreads();
}
struct EpiScaleBf16 {
    static constexpr bool PERM = true, AFTER_DRAIN = false;
    bf16_t* O; int ldc; const PG8_LAS float* rst;
    __device__ __forceinline__ void operator()(const f32x4 (&acc)[2][2][4][2], const Unit& u, int wr, int wc, int fr, int fq, int ui) const {
        const int row0 = u.pm * BM + wr * 64 + fr, col0 = u.pn * BM + wc * 32 + 8 * fq;
        float rs[2][4]; rstd_from_table(rst + ui * 256 + wr * 64 + fr, rs);
#pragma unroll
        for (int ai = 0; ai < 2; ++ai)
#pragma unroll
            for (int m = 0; m < 4; ++m) { bf16_t* rowp = O + (size_t)(row0 + ai * HALF + m * 16) * ldc + col0; const float r = rs[ai][m];
#pragma unroll
                for (int bj = 0; bj < 2; ++bj) { const f32x4 v0 = acc[ai][bj][m][0] * r, v1 = acc[ai][bj][m][1] * r;
                    u32x4 w; w.x = cvt_pk_bf16(v0[0], v0[1]); w.y = cvt_pk_bf16(v0[2], v0[3]); w.z = cvt_pk_bf16(v1[0], v1[1]); w.w = cvt_pk_bf16(v1[2], v1[3]);
                    *(u32x4*)(rowp + bj * HALF) = w; } }
    }
};
__device__ __forceinline__ float silu_f(float g) { return g * __builtin_amdgcn_rcpf(1.0f + __expf(-g)); }
struct EpiSwiGLU {
    static constexpr bool PERM = true, AFTER_DRAIN = false;
    bf16_t* O; int ldc; const PG8_LAS float* rst;
    __device__ __forceinline__ void operator()(const f32x4 (&acc)[2][2][4][2], const Unit& u, int wr, int wc, int fr, int fq, int ui) const {
        const int row0 = u.pm * BM + wr * 64 + fr, col0 = u.pn * HALF + wc * 32 + 8 * fq;
        float rs[2][4]; rstd_from_table(rst + ui * 256 + wr * 64 + fr, rs);
#pragma unroll
        for (int ai = 0; ai < 2; ++ai)
#pragma unroll
            for (int m = 0; m < 4; ++m) { bf16_t* rowp = O + (size_t)(row0 + ai * HALF + m * 16) * ldc + col0; const float r = rs[ai][m];
                float o[8];
#pragma unroll
                for (int n = 0; n < 2; ++n)
#pragma unroll
                    for (int e = 0; e < 4; ++e) { const float g = acc[ai][0][m][n][e] * r, up = acc[ai][1][m][n][e] * r; o[n * 4 + e] = silu_f(g) * up; }
                u32x4 w; w.x = cvt_pk_bf16(o[0], o[1]); w.y = cvt_pk_bf16(o[2], o[3]); w.z = cvt_pk_bf16(o[4], o[5]); w.w = cvt_pk_bf16(o[6], o[7]);
                *(u32x4*)rowp = w; }
    }
};
template <int MODE> struct EpiResid {
    static constexpr bool PERM = false, AFTER_DRAIN = false;
    const float* base; float* out; bf16_t* xb; float* ssq;
    __device__ __forceinline__ void operator()(const f32x4 (&acc)[2][2][4][2], const Unit& u, int wr, int wc, int fr, int fq, int) const {
        const int row0 = u.pm * BM + wr * 64 + fr, col0 = u.pn * BM + wc * 32 + 4 * fq;
#pragma unroll
        for (int ai = 0; ai < 2; ++ai)
#pragma unroll
            for (int m = 0; m < 4; ++m) { const int row = row0 + ai * HALF + m * 16; const size_t off = (size_t)row * 2048 + col0; float s = 0.f;
#pragma unroll
                for (int bj = 0; bj < 2; ++bj)
#pragma unroll
                    for (int n = 0; n < 2; ++n) { const size_t o2 = off + bj * HALF + n * 16; f32x4 bs;
                        if (MODE == 0) bs = __builtin_nontemporal_load((const f32x4*)(base + o2));
                        else { const u32x2 b2 = *(const u32x2*)(xb + o2); bs[0] = __builtin_bit_cast(float, b2.x << 16); bs[1] = __builtin_bit_cast(float, b2.x & 0xffff0000u); bs[2] = __builtin_bit_cast(float, b2.y << 16); bs[3] = __builtin_bit_cast(float, b2.y & 0xffff0000u); }
                        const f32x4 o = bs + acc[ai][bj][m][n];
                        if (MODE == 2) __builtin_nontemporal_store(o, (f32x4*)(out + o2));
                        else { s += (o[0] * o[0] + o[1] * o[1]) + (o[2] * o[2] + o[3] * o[3]); u32x2 w; w.x = cvt_pk_bf16(o[0], o[1]); w.y = cvt_pk_bf16(o[2], o[3]); *(u32x2*)(xb + o2) = w; } }
                if (MODE != 2) { s += __shfl_xor(s, 16); s += __shfl_xor(s, 32); if (fq == 0) ssq[(size_t)row * 32 + u.pn * 4 + wc] = s; } }
    }
};
template <class Epi, class Sched, bool ALIGN_EPI = false, bool SP2 = false>
__device__ __forceinline__ void gemm_phase(PG8_LAS unsigned char* lds, const Gemm g, const Sched& S, const Epi& E) {
    const int tid = opaque_tid(), wid = __builtin_amdgcn_readfirstlane(tid >> 6), lane = tid & 63, wr = wid >> 2, wc = wid & 3, fr = lane & 15, fq = lane >> 4;
    const int K = g.K, nt = K / BK;
    unsigned voffA[2], voffB[2];
#pragma unroll
    for (int i = 0; i < 2; ++i) { int R, C; stage_rc(tid * 16 + i * 8192, R, C); const int Rb = Epi::PERM ? ((R & ~31) + perm32(R & 31)) : R;
        voffA[i] = (unsigned)(R * K + C) * 2u; voffB[i] = (unsigned)(Rb * K + C) * 2u; }
    const size_t kstep = (size_t)(BK * 2);
    const size_t hstep = (size_t)HALF * K * 2;
    const size_t tstep = 2 * hstep;
    const unsigned ldsw = (unsigned)wid * 1024u;
    const int aoff = lds_byte(wr * 64 + fr, fq * 8), boff = lds_byte(wc * 32 + fr, fq * 8);
#define PG8_SA(b, h) (((b) * 2 + (h)) * HTB)
#define PG8_SB(b, h) ((4 + (b) * 2 + (h)) * HTB)
#define PG8_STAGE(bufoff, gbase, voff) do { _Pragma("unroll") for (int _i = 0; _i < 2; ++_i) \
        __builtin_amdgcn_global_load_lds((const unsigned*)((const char*)(gbase) + (voff)[_i]), (PG8_LAS unsigned*)(lds + (bufoff) + ldsw + _i * 8192), 16, 0, 0); } while (0)
#define PG8_LDA(dst, b, h) do { _Pragma("unroll") for (int m = 0; m < 4; ++m) _Pragma("unroll") for (int k = 0; k < 2; ++k) dst[m][k] = *(const PG8_LAS bf16x8*)(lds + PG8_SA(b, h) + aoff + m * 2048 + k * 1024); } while (0)
#define PG8_LDB(dst, b, h) do { _Pragma("unroll") for (int n = 0; n < 2; ++n) _Pragma("unroll") for (int k = 0; k < 2; ++k) dst[n][k] = *(const PG8_LAS bf16x8*)(lds + PG8_SB(b, h) + boff + n * 2048 + k * 1024); } while (0)
#define PG8_MMA(ai, bj, At, Bt) do { __builtin_amdgcn_s_setprio(1); _Pragma("unroll") for (int m = 0; m < 4; ++m) _Pragma("unroll") for (int n = 0; n < 2; ++n) _Pragma("unroll") for (int k = 0; k < 2; ++k) \
        acc[ai][bj][m][n] = __builtin_amdgcn_mfma_f32_16x16x32_bf16(Bt[n][k], At[m][k], acc[ai][bj][m][n], 0, 0, 0); __builtin_amdgcn_s_setprio(0); } while (0)
#define PG8_WAIT_V(n) asm volatile("s_waitcnt vmcnt(" #n ")" ::: "memory")
#define PG8_WAIT_L(n) asm volatile("s_waitcnt lgkmcnt(" #n ")" ::: "memory")
#define PG8_BAR __builtin_amdgcn_s_barrier()
#define PG8_SCHED __builtin_amdgcn_sched_barrier(0)
    Unit cur, nxt; int ui = 0;
    if (!S.next(0, cur)) return;
    f32x4 acc[2][2][4][2];
#pragma unroll
    for (int a = 0; a < 2; ++a)
#pragma unroll
        for (int b = 0; b < 2; ++b)
#pragma unroll
            for (int m = 0; m < 4; ++m)
#pragma unroll
                for (int n = 0; n < 2; ++n) acc[a][b][m][n] = (f32x4){0.f, 0.f, 0.f, 0.f};
    bf16x8 At[4][2], B0[2][2], B1[2][2];
    const char* cA = (const char*)g.A + (size_t)cur.pm * tstep; const char* cB = (const char*)g.Bt + (size_t)cur.pn * tstep;
    S.a_ready(cur);
    if constexpr (SP2) {
        PG8_STAGE(PG8_SB(0, 0), cB, voffB); PG8_STAGE(PG8_SB(0, 1), cB + hstep, voffB); PG8_STAGE(PG8_SA(0, 0), cA, voffA); PG8_STAGE(PG8_SA(0, 1), cA + hstep, voffA);
        if (wr == 1) PG8_BAR;
        PG8_WAIT_V(2); PG8_BAR;
        PG8_STAGE(PG8_SB(1, 0), cB + kstep, voffB); PG8_STAGE(PG8_SA(1, 0), cA + kstep, voffA); PG8_STAGE(PG8_SB(1, 1), cB + hstep + kstep, voffB);
        PG8_WAIT_V(6); PG8_BAR;
    } else {
        PG8_STAGE(PG8_SB(0, 0), cB, voffB); PG8_STAGE(PG8_SA(0, 0), cA, voffA); PG8_STAGE(PG8_SB(0, 1), cB + hstep, voffB); PG8_STAGE(PG8_SA(0, 1), cA + hstep, voffA);
        if (wr == 1) PG8_BAR;
        PG8_WAIT_V(4); PG8_BAR;
        PG8_STAGE(PG8_SB(1, 0), cB + kstep, voffB); PG8_STAGE(PG8_SA(1, 0), cA + kstep, voffA); PG8_STAGE(PG8_SB(1, 1), cB + hstep + kstep, voffB);
        PG8_WAIT_V(6); PG8_BAR;
    }
    for (;;) {
        const bool has_next = S.next(ui + 1, nxt);
        const char* nA = has_next ? (const char*)g.A + (size_t)nxt.pm * tstep : cA; const char* nB = has_next ? (const char*)g.Bt + (size_t)nxt.pn * tstep : cB;
        for (int t = 0; t < nt; t += 2) {
            const bool last = (t == nt - 2);
            const char* a1 = cA + (size_t)(t + 1) * kstep;
            const char* a2 = last ? nA : cA + (size_t)(t + 2) * kstep; const char* b2 = last ? nB : cB + (size_t)(t + 2) * kstep;
            const char* a3 = a2 + kstep; const char* b3 = b2 + kstep;
            if (last && has_next) S.a_ready(nxt);
            if constexpr (SP2) {
            PG8_LDB(B0, 0, 0); PG8_LDB(B1, 0, 1); PG8_SCHED; PG8_LDA(At, 0, 0); PG8_STAGE(PG8_SA(1, 1), a1 + hstep, voffA);
            PG8_WAIT_V(8); PG8_WAIT_L(0); PG8_BAR; PG8_MMA(0, 0, At, B0); PG8_MMA(0, 1, At, B1); PG8_BAR; PG8_SCHED;
            PG8_LDA(At, 0, 1); PG8_STAGE(PG8_SB(0, 0), b2, voffB); PG8_STAGE(PG8_SB(0, 1), b2 + hstep, voffB); PG8_STAGE(PG8_SA(0, 0), a2, voffA);
            PG8_WAIT_V(8); PG8_WAIT_L(0); PG8_BAR; PG8_MMA(1, 0, At, B0); PG8_MMA(1, 1, At, B1); PG8_BAR; PG8_SCHED;
            PG8_LDB(B0, 1, 0); PG8_LDB(B1, 1, 1); PG8_SCHED; PG8_LDA(At, 1, 0); PG8_STAGE(PG8_SA(0, 1), a2 + hstep, voffA);
            PG8_WAIT_V(8); PG8_WAIT_L(0); PG8_BAR; PG8_MMA(0, 0, At, B0); PG8_MMA(0, 1, At, B1); PG8_BAR; PG8_SCHED;
            PG8_LDA(At, 1, 1); PG8_STAGE(PG8_SB(1, 0), b3, voffB); PG8_STAGE(PG8_SB(1, 1), b3 + hstep, voffB); PG8_STAGE(PG8_SA(1, 0), a3, voffA);
            PG8_WAIT_V(8); PG8_WAIT_L(0); PG8_BAR; PG8_MMA(1, 0, At, B0); PG8_MMA(1, 1, At, B1); PG8_BAR; PG8_SCHED;
            } else {
            PG8_LDB(B0, 0, 0); PG8_SCHED; PG8_LDA(At, 0, 0); PG8_STAGE(PG8_SA(1, 1), a1 + hstep, voffA);
            PG8_WAIT_L(8); PG8_BAR; PG8_WAIT_L(0); PG8_MMA(0, 0, At, B0); PG8_BAR; PG8_SCHED;
            PG8_LDB(B1, 0, 1); PG8_STAGE(PG8_SB(0, 0), b2, voffB);
            PG8_BAR; PG8_WAIT_L(0); PG8_MMA(0, 1, At, B1); PG8_BAR;
            PG8_LDA(At, 0, 1); PG8_STAGE(PG8_SA(0, 0), a2, voffA);
            PG8_BAR; PG8_WAIT_L(0); PG8_MMA(1, 0, At, B0); PG8_BAR; PG8_SCHED;
            PG8_STAGE(PG8_SB(0, 1), b2 + hstep, voffB);
            PG8_WAIT_V(6); PG8_BAR; PG8_MMA(1, 1, At, B1); PG8_BAR;
            PG8_LDB(B0, 1, 0); PG8_SCHED; PG8_LDA(At, 1, 0); PG8_STAGE(PG8_SA(0, 1), a2 + hstep, voffA);
            PG8_WAIT_L(8); PG8_BAR; PG8_WAIT_L(0); PG8_MMA(0, 0, At, B0); PG8_BAR; PG8_SCHED;
            PG8_LDB(B1, 1, 1); PG8_STAGE(PG8_SB(1, 0), b3, voffB);
            PG8_BAR; PG8_WAIT_L(0); PG8_MMA(0, 1, At, B1); PG8_BAR;
            PG8_LDA(At, 1, 1); PG8_STAGE(PG8_SA(1, 0), a3, voffA);
            PG8_BAR; PG8_WAIT_L(0); PG8_MMA(1, 0, At, B0); PG8_BAR; PG8_SCHED;
            PG8_STAGE(PG8_SB(1, 1), b3 + hstep, voffB);
            PG8_WAIT_V(6); PG8_BAR; PG8_MMA(1, 1, At, B1); PG8_BAR;
            }
        }
        if constexpr (ALIGN_EPI) { if (wr == 0) PG8_BAR; }
        if constexpr (!Epi::AFTER_DRAIN) { E(acc, cur, wr, wc, fr, fq, ui); S.done(cur); }
        if (!has_next) break;
#pragma unroll
        for (int a = 0; a < 2; ++a)
#pragma unroll
            for (int b = 0; b < 2; ++b)
#pragma unroll
                for (int m = 0; m < 4; ++m)
#pragma unroll
                    for (int n = 0; n < 2; ++n) acc[a][b][m][n] = (f32x4){0.f, 0.f, 0.f, 0.f};
        cur = nxt; cA = nA; cB = nB; ++ui;
        if constexpr (ALIGN_EPI) { if (wr == 1) PG8_BAR; }
    }
    PG8_WAIT_V(0);
    if constexpr (!ALIGN_EPI) { if (wr == 0) PG8_BAR; }
    PG8_BAR;
    if constexpr (Epi::AFTER_DRAIN) { E.fused(acc, cur, wr, wc, fr, fq, lds, wid, lane); S.done(cur); }
#undef PG8_SA
#undef PG8_SB
#undef PG8_STAGE
#undef PG8_LDA
#undef PG8_LDB
#undef PG8_MMA
#undef PG8_WAIT_V
#undef PG8_WAIT_L
#undef PG8_BAR
#undef PG8_SCHED
}
}
constexpr int M = 8192, SEQ = 4096, DM = 2048, DFF = 5632;
constexpr int GLA_LD = 6160, FOX_LD = 8208;
constexpr int LD0 = 6144;
constexpr int LD1 = 8192;
constexpr int NWAVES = 8, NTHREADS = 512;
constexpr int LDS_BYTES = 151552;
constexpr size_t MiB = 1u << 20;
constexpr size_t WS_WG2 = 0, WS_BG2 = 65536, WS_OGAIN = 69632, WS_BF = 71680, WS_QGAIN = 71936, WS_KGAIN = 72448;
constexpr size_t WS_THR = 73728;
constexpr size_t WS_BAR = 131072;
constexpr size_t WS_SSQ = 1 * MiB, WS_GLR = 2 * MiB, WS_EL = 2 * MiB + 512 * 1024, WS_CF = 3 * MiB, WS_W1T = 4 * MiB, WS_WFT = 4 * MiB + 65536;
constexpr size_t WS_WGI = 8 * MiB, WS_WGO = 32 * MiB, WS_WGU0 = 40 * MiB, WS_WD0 = 84 * MiB, WS_WFI = 106 * MiB, WS_WFO = 138 * MiB, WS_WGU1 = 146 * MiB, WS_WD1 = 190 * MiB;
constexpr size_t WS_XB = 212 * MiB, WS_OB = 244 * MiB, WS_PROJ = 276 * MiB, WS_QT = 404 * MiB, WS_KDT = 420 * MiB, WS_AM = 436 * MiB, WS_ST1 = 440 * MiB, WS_END = 470 * MiB;
constexpr size_t WS_VT = WS_PROJ + 96 * MiB;
constexpr size_t WS_ST0 = WS_WGU1;

#define LAS __attribute__((address_space(3)))
typedef unsigned short bf16;
__device__ __forceinline__ bf16* st_ptr(unsigned char* ws, int pu) { return (bf16*)(ws + (pu < 392 ? WS_ST0 + (size_t)pu * 262144 : WS_ST1 + (size_t)(pu - 392) * 262144)); }
typedef unsigned v4u __attribute__((ext_vector_type(4)));
typedef unsigned v2u __attribute__((ext_vector_type(2)));
typedef float f32x4 __attribute__((ext_vector_type(4)));
typedef float f32x16 __attribute__((ext_vector_type(16)));
typedef short bf16x8 __attribute__((ext_vector_type(8)));
typedef short s16x4 __attribute__((ext_vector_type(4)));
#define SBAR() __builtin_amdgcn_sched_barrier(0)
#define LDS_WAIT() asm volatile("s_waitcnt lgkmcnt(0)" ::: "memory")
__device__ __forceinline__ unsigned f2bf(float f) { return cvtpk(f, 0.f) & 0xffffu; }
__device__ __forceinline__ unsigned pk2(float lo, float hi) { return cvtpk(lo, hi); }
__device__ __forceinline__ float bf2f(unsigned short b) { return __builtin_bit_cast(float, (unsigned)b << 16); }
__device__ __forceinline__ float wave_sum(float v) {
#pragma unroll
    for (int o = 1; o < 64; o <<= 1) v += __shfl_xor(v, o);
    return v;
}

struct Params {
    const float* x; const float* norm_mix; const float* norm_ffn; const float* gla_w_in; const float* gla_w_g2; const float* gla_b_g2; const float* gla_o_gain; const float* gla_w_o;
    const float* fox_w_in; const float* fox_b_f; const float* fox_q_gain; const float* fox_k_gain; const float* fox_w_o; const float* ffn_w_gate; const float* ffn_w_up; const float* ffn_w_down;
    float* out; unsigned char* ws; int ph_lo, ph_hi;
};

struct TJob { const float* src; const float* gain; bf16* dst; int ld, K; };
__device__ __forceinline__ void tj_load(const TJob& j, f32x4 (&v)[8]) {
#pragma unroll
    for (int r = 0; r < 8; ++r) v[r] = __builtin_nontemporal_load((const f32x4*)(j.src + (size_t)r * j.ld));
}
__device__ __forceinline__ void tj_store(const TJob& j, f32x4 (&v)[8]) {
    if (j.gain) { const f32x4 g0 = *(const f32x4*)j.gain, g1 = *(const f32x4*)(j.gain + 4);
#pragma unroll
        for (int r = 0; r < 8; ++r) v[r] = v[r] * (r < 4 ? g0[r] : g1[r - 4]); }
#pragma unroll
    for (int c = 0; c < 4; ++c) { v4u w; w.x = cvtpk(v[0][c], v[1][c]); w.y = cvtpk(v[2][c], v[3][c]); w.z = cvtpk(v[4][c], v[5][c]); w.w = cvtpk(v[6][c], v[7][c]);
        *(v4u*)(j.dst + (size_t)c * j.K) = w; }
}
__device__ __forceinline__ void p0_prologue(const Params& P, LAS unsigned char* lds, int part, int blk, int nblk_) {
    const int tid = opaque_tid(), lane = tid & 63, wave = tid >> 6;
    const int gw = blk * NWAVES + wave, NGW = nblk_ * NWAVES;
    unsigned char* ws = P.ws;
    constexpr int I_A = 32 * 192, I_B = 32 * 64, I_C = 32 * 176, I_D = 88 * 64;
    constexpr int NITEMS = 2 * I_A + 3 * I_B + 4 * I_C + 2 * I_D;
    auto decode = [&](int it) -> TJob {
        int r = it; const float* W; int ld, col0 = 0, K = 2048, nblk, mode = 0; const float* gain = nullptr; bf16* WT; int rowoff = 0;
        if (r < I_A) { W = P.gla_w_in; ld = GLA_LD; nblk = 192; gain = P.norm_mix; WT = (bf16*)(ws + WS_WGI); }
        else if ((r -= I_A) < I_B) { W = P.gla_w_o; ld = 2048; nblk = 64; WT = (bf16*)(ws + WS_WGO); }
        else if ((r -= I_B) < I_C) { W = P.ffn_w_gate; ld = DFF; nblk = 176; gain = P.norm_ffn; WT = (bf16*)(ws + WS_WGU0); mode = 1; }
        else if ((r -= I_C) < I_C) { W = P.ffn_w_up; ld = DFF; nblk = 176; gain = P.norm_ffn; WT = (bf16*)(ws + WS_WGU0); mode = 1; rowoff = 128; }
        else if ((r -= I_C) < I_D) { W = P.ffn_w_down; ld = 2048; nblk = 64; K = DFF; WT = (bf16*)(ws + WS_WD0); }
        else if ((r -= I_D) < I_A) { W = P.fox_w_in; ld = FOX_LD; nblk = 192; gain = P.norm_mix + DM; WT = (bf16*)(ws + WS_WFI); }
        else if ((r -= I_A) < I_B) { W = P.fox_w_in; ld = FOX_LD; col0 = 6160; nblk = 64; gain = P.norm_mix + DM; WT = (bf16*)(ws + WS_WFI); rowoff = 6144; }
        else if ((r -= I_B) < I_B) { W = P.fox_w_o; ld = 2048; nblk = 64; WT = (bf16*)(ws + WS_WFO); }
        else if ((r -= I_B) < I_C) { W = P.ffn_w_gate + (size_t)DM * DFF; ld = DFF; nblk = 176; gain = P.norm_ffn + DM; WT = (bf16*)(ws + WS_WGU1); mode = 1; }
        else if ((r -= I_C) < I_C) { W = P.ffn_w_up + (size_t)DM * DFF; ld = DFF; nblk = 176; gain = P.norm_ffn + DM; WT = (bf16*)(ws + WS_WGU1); mode = 1; rowoff = 128; }
        else { r -= I_C; W = P.ffn_w_down + (size_t)DFF * DM; ld = 2048; nblk = 64; K = DFF; WT = (bf16*)(ws + WS_WD1); }
        const int kb = r / nblk, nb = r % nblk, n0 = nb * 32, k0 = kb * 64 + 8 * (lane >> 3), c4 = lane & 7;
        const int drow0 = (mode ? ((n0 >> 7) * 256 + (n0 & 127)) : n0) + rowoff;
        TJob j; j.src = W + (size_t)k0 * ld + col0 + n0 + 4 * c4; j.gain = gain ? gain + k0 : nullptr; j.dst = WT + (size_t)(drow0 + 4 * c4) * K + k0; j.ld = ld; j.K = K; return j;
    };
    constexpr int NITEMS_A = I_A + I_B + 2 * I_C + I_D + I_A, NITEMS_B = NITEMS_A + 2 * I_B + 2 * I_C;
    const int it_lo = part == 0 ? 0 : (part == 1 ? NITEMS_A : NITEMS_B), it_hi = part == 0 ? NITEMS_A : (part == 1 ? NITEMS_B : NITEMS);
    { int it = it_lo + gw;
      if (it < it_hi) {
        bool h1 = it + NGW < it_hi; TJob j0 = decode(it), j1 = decode(h1 ? it + NGW : it);
        f32x4 va[8], vb[8]; tj_load(j0, va); tj_load(j1, vb);
        for (;;) {
            const int itn = it + 2 * NGW; const bool more = itn < it_hi;
            const bool h1n = more && (itn + NGW < it_hi);
            const TJob n0 = decode(more ? itn : it), n1 = decode(h1n ? itn + NGW : (more ? itn : it));
            f32x4 vc[8], vd[8];
            if (more) { tj_load(n0, vc); tj_load(n1, vd); }
            tj_store(j0, va); if (h1) tj_store(j1, vb);
            if (!more) break;
#pragma unroll
            for (int r = 0; r < 8; ++r) { va[r] = vc[r]; vb[r] = vd[r]; }
            j0 = n0; j1 = n1; h1 = h1n; it = itn;
        }
      } }
    if (part) return;
    for (int e = blockIdx.x * NTHREADS + tid; e < 65536; e += gridDim.x * NTHREADS) {
        const int which = e >> 15, idx = e & 32767, k = idx >> 4, c = idx & 15;
        const float v = which ? P.fox_w_in[(size_t)k * FOX_LD + 6144 + c] * P.norm_mix[DM + k] : P.gla_w_in[(size_t)k * GLA_LD + 6144 + c] * P.norm_mix[k];
        ((bf16*)(ws + (which ? WS_WFT : WS_W1T)))[c * 2048 + k] = (bf16)f2bf(v);
    }
    for (int e = blockIdx.x * NTHREADS + tid; e < 16384 + 1024 + 512 + 16 + 128 + 128; e += gridDim.x * NTHREADS) {
        if (e < 16384) ((float*)(ws + WS_WG2))[e] = P.gla_w_g2[e];
        else if (e < 17408) ((float*)(ws + WS_BG2))[e - 16384] = P.gla_b_g2[e - 16384];
        else if (e < 17920) ((float*)(ws + WS_OGAIN))[e - 17408] = P.gla_o_gain[e - 17408];
        else if (e < 17936) ((float*)(ws + WS_BF))[e - 17920] = P.fox_b_f[e - 17920];
        else if (e < 18064) ((float*)(ws + WS_QGAIN))[e - 17936] = P.fox_q_gain[e - 17936];
        else ((float*)(ws + WS_KGAIN))[e - 18064] = P.fox_k_gain[e - 18064];
    }
    bf16* XB = (bf16*)(ws + WS_XB); float* SSQ = (float*)(ws + WS_SSQ);
    for (int m = gw; m < M; m += 2 * NGW) {
        const int m1 = m + NGW; const bool h1 = m1 < M;
        const f32x4* xr0 = (const f32x4*)(P.x + (size_t)m * DM) + lane; const f32x4* xr1 = (const f32x4*)(P.x + (size_t)(h1 ? m1 : m) * DM) + lane;
        f32x4 v0[8], v1[8]; float s0 = 0.f, s1 = 0.f;
#pragma unroll
        for (int j = 0; j < 8; ++j) { v0[j] = __builtin_nontemporal_load(xr0 + 64 * j); v1[j] = __builtin_nontemporal_load(xr1 + 64 * j); }
#pragma unroll
        for (int j = 0; j < 8; ++j) { s0 += (v0[j][0] * v0[j][0] + v0[j][1] * v0[j][1]) + (v0[j][2] * v0[j][2] + v0[j][3] * v0[j][3]); s1 += (v1[j][0] * v1[j][0] + v1[j][1] * v1[j][1]) + (v1[j][2] * v1[j][2] + v1[j][3] * v1[j][3]); }
        s0 = wave_sum(s0); s1 = wave_sum(s1);
        v2u* o0 = (v2u*)(XB + (size_t)m * DM) + lane;
#pragma unroll
        for (int j = 0; j < 8; ++j) { v2u w; w.x = pk2(v0[j][0], v0[j][1]); w.y = pk2(v0[j][2], v0[j][3]); o0[64 * j] = w; }
        if (lane < 32) SSQ[(size_t)m * 32 + lane] = lane == 0 ? s0 : 0.f;
        if (h1) { v2u* o1 = (v2u*)(XB + (size_t)m1 * DM) + lane;
#pragma unroll
            for (int j = 0; j < 8; ++j) { v2u w; w.x = pk2(v1[j][0], v1[j][1]); w.y = pk2(v1[j][2], v1[j][3]); o1[64 * j] = w; }
            if (lane < 32) SSQ[(size_t)m1 * 32 + lane] = lane == 0 ? s1 : 0.f; }
    }
}

__device__ __forceinline__ void thin_gemm(const bf16* XB, const bf16* WT, const float* SSQ, float* OUT, LAS unsigned char* lds) {
    const int tid = opaque_tid(), lane = tid & 63, wave = tid >> 6, fr = lane & 15, q = lane >> 4, grp = wave >> 2, wk = wave & 3;
    LAS f32x4* red = (LAS f32x4*)lds;
    for (int t0 = 2 * blockIdx.x; t0 < M / 16; t0 += 2 * gridDim.x) { const int tile = t0 + grp;
        f32x4 acc = {0.f, 0.f, 0.f, 0.f};
        const bf16* ap = XB + (size_t)(tile * 16 + fr) * DM + wk * 512 + q * 8; const bf16* bp = WT + (size_t)fr * DM + wk * 512 + q * 8;
        float t4[4] = {0.f, 0.f, 0.f, 0.f};
        if (wk == 0) {
#pragma unroll
            for (int i = 0; i < 4; ++i) { const f32x4* p = (const f32x4*)(SSQ + (size_t)(tile * 16 + 4 * q + i) * 32);
#pragma unroll
                for (int j = 0; j < 8; ++j) { const f32x4 a = p[j]; t4[i] += (a[0] + a[1]) + (a[2] + a[3]); } } }
#pragma unroll
        for (int kb = 0; kb < 16; ++kb) { const bf16x8 a = *(const bf16x8*)(ap + kb * 32), b = *(const bf16x8*)(bp + kb * 32); acc = __builtin_amdgcn_mfma_f32_16x16x32_bf16(a, b, acc, 0, 0, 0); }
        red[wave * 64 + lane] = acc;
        __syncthreads();
        if (wk == 0) {
            f32x4 s = red[wave * 64 + lane];
#pragma unroll
            for (int w = 1; w < 4; ++w) s += red[(wave + w) * 64 + lane];
#pragma unroll
            for (int i = 0; i < 4; ++i) OUT[(size_t)(tile * 16 + 4 * q + i) * 16 + fr] = s[i] / sqrtf(t4[i] * (1.0f / 2048.0f) + 1e-6f);
        }
        __syncthreads();
    }
}
__device__ __forceinline__ float log_sigmoid_f(float z) { return fminf(z, 0.f) - __logf(1.0f + __expf(-fabsf(z))); }
__device__ __forceinline__ void gla_prep_unit(const Params& P, LAS unsigned char* lds, int u) {
    const int tid = opaque_tid(), lane = tid & 63, wave = tid >> 6, fr = lane & 15, q4 = lane >> 4;
    const int ch = u & 63, h = (u >> 6) & 3, b = u >> 8, tok0 = b * SEQ + ch * 64;
    unsigned char* ws = P.ws;
    LAS float* Bs = (LAS float*)lds;
    LAS bf16* QS = (LAS bf16*)(lds + 65536);
    LAS bf16* KS = (LAS bf16*)(lds + 65536 + 33792);
    LAS float* GL = (LAS float*)(lds + 133120);
    LAS float* TOT = (LAS float*)(lds + 137216);
    const float* GLR = (const float*)(ws + WS_GLR); const bf16* PROJ = (const bf16*)(ws + WS_PROJ);
    bf16* QT = (bf16*)(ws + WS_QT); bf16* KDT = (bf16*)(ws + WS_KDT); bf16* AM = (bf16*)(ws + WS_AM); float* EL = (float*)(ws + WS_EL);
    v4u rq[4], rk[4];
#pragma unroll
    for (int it = 0; it < 4; ++it) { const int idx = it * NTHREADS + tid, t = idx >> 5, cc = idx & 31; const bf16* p = PROJ + (size_t)(tok0 + t) * LD0 + 256 * h + 8 * cc; rq[it] = __builtin_nontemporal_load((const v4u*)p); rk[it] = __builtin_nontemporal_load((const v4u*)(p + 1024)); }
    if (tid < 256) ((LAS f32x4*)GL)[tid] = ((const f32x4*)(GLR + (size_t)tok0 * 16))[tid];
    const int c = tid & 255, th = tid >> 8;
    float w2[16];
#pragma unroll
    for (int j = 0; j < 16; ++j) w2[j] = ((const float*)(ws + WS_WG2))[j * 1024 + 256 * h + c];
    const float bias = ((const float*)(ws + WS_BG2))[256 * h + c];
    __syncthreads();
    float cum = 0.f;
#pragma unroll 4
    for (int tt = 0; tt < 32; ++tt) { const int t = 32 * th + tt; float z = bias;
#pragma unroll
        for (int j = 0; j < 16; ++j) z += GL[t * 16 + j] * w2[j];
        cum += log_sigmoid_f(z) * (1.0f / 16.0f); Bs[t * 256 + c] = cum; }
    TOT[th * 256 + c] = cum;
#pragma unroll
    for (int it = 0; it < 4; ++it) { const int idx = it * NTHREADS + tid, t = idx >> 5, cc = idx & 31; *(LAS v4u*)(QS + t * 264 + 8 * cc) = rq[it]; *(LAS v4u*)(KS + t * 264 + 8 * cc) = rk[it]; }
    v4u rv[8];
#pragma unroll
    for (int it = 0; it < 8; ++it) { const int idx = it * NTHREADS + tid, t = idx >> 6, cc = idx & 63; rv[it] = __builtin_nontemporal_load((const v4u*)(PROJ + (size_t)(tok0 + t) * LD0 + 2048 + 512 * h + 8 * cc)); }
    __syncthreads();
    const float off = th ? TOT[c] : 0.f, blast = TOT[c] + TOT[256 + c], eblast = __expf(blast);
    for (int g8 = 0; g8 < 4; ++g8) { unsigned kdp[8];
#pragma unroll
        for (int e = 0; e < 8; ++e) { const int t = 32 * th + g8 * 8 + e; const float bb = Bs[t * 256 + c] + off;
            const float qv = bf2f(QS[t * 264 + c]), kv = bf2f(KS[t * 264 + c]);
            const float eb = __expf(bb), qt = qv * 0.0625f * eb, kt = kv * __expf(-bb), kd = kt * eblast;
            QS[t * 264 + c] = (bf16)f2bf(qt); KS[t * 264 + c] = (bf16)f2bf(kt); kdp[e] = f2bf(kd); }
        v4u o; o.x = kdp[0] | (kdp[1] << 16); o.y = kdp[2] | (kdp[3] << 16); o.z = kdp[4] | (kdp[5] << 16); o.w = kdp[6] | (kdp[7] << 16);
        *(v4u*)(KDT + ((size_t)u * 256 + c) * 64 + 32 * th + g8 * 8) = o; }
    if (th == 0) EL[(size_t)u * 256 + c] = eblast;
    __syncthreads();
    LAS bf16* VS = (LAS bf16*)lds;
#pragma unroll
    for (int it = 0; it < 8; ++it) { const int idx = it * NTHREADS + tid, t = idx >> 6, cc = idx & 63; *(LAS v4u*)(VS + t * 512 + 8 * (cc ^ ((t >> 3) & 7))) = rv[it]; }
#pragma unroll
    for (int it = 0; it < 4; ++it) { const int idx = it * NTHREADS + tid, t = idx >> 5, cc = idx & 31; *(v4u*)(QT + ((size_t)u * 64 + t) * 256 + 8 * cc) = *(const LAS v4u*)(QS + t * 264 + 8 * cc); }
#pragma unroll
    for (int rep = 0; rep < 2; ++rep) { const int idx = wave + 8 * rep, mi = idx >> 2, si = idx & 3;
        f32x4 acc = {0.f, 0.f, 0.f, 0.f};
        if (si <= mi) {
#pragma unroll
            for (int kb = 0; kb < 8; ++kb) { const bf16x8 a = *(const LAS bf16x8*)(KS + (16 * si + fr) * 264 + 32 * kb + 8 * q4), bq = *(const LAS bf16x8*)(QS + (16 * mi + fr) * 264 + 32 * kb + 8 * q4);
                acc = __builtin_amdgcn_mfma_f32_16x16x32_bf16(a, bq, acc, 0, 0, 0); }
        }
        const int t = 16 * mi + fr; float o4[4];
#pragma unroll
        for (int i = 0; i < 4; ++i) { const int s = 16 * si + 4 * q4 + i; o4[i] = (s <= t) ? acc[i] : 0.f; }
        v2u w; w.x = pk2(o4[0], o4[1]); w.y = pk2(o4[2], o4[3]);
        *(v2u*)(AM + ((size_t)u * 64 + t) * 64 + 16 * si + 4 * q4) = w; }
    __syncthreads();
    { const int vv = lane >> 3, tc = lane & 7;
#pragma unroll
      for (int i = 0; i < 8; ++i) { const int v = 64 * wave + 8 * i + vv; const LAS bf16* src = VS + (8 * tc) * 512 + (((v >> 3) ^ tc) * 8) + (v & 7); unsigned e[8];
#pragma unroll
          for (int j = 0; j < 8; ++j) e[j] = src[j * 512];
          v4u o; o.x = e[0] | (e[1] << 16); o.y = e[2] | (e[3] << 16); o.z = e[4] | (e[5] << 16); o.w = e[6] | (e[7] << 16);
          *(v4u*)((bf16*)(ws + WS_VT) + ((size_t)u * 512 + v) * 64 + 8 * tc) = o; } }
    __syncthreads();
}
__device__ __forceinline__ void gla_scan_unit(const Params& P, LAS unsigned char* lds, int u) {
    const int tid = opaque_tid(), lane = tid & 63, wave = tid >> 6, fr = lane & 15, q4 = lane >> 4;
    const int bh = u >> 5, kblk = (u >> 3) & 3, vblk = u & 7, pu0 = bh * 64;
    unsigned char* ws = P.ws;
    const bf16* kdsrc = (const bf16*)(ws + WS_KDT) + ((size_t)pu0 * 256 + 64 * kblk) * 64 + tid * 8;
    const bf16* vtsrc = (const bf16*)(ws + WS_VT) + ((size_t)pu0 * 512 + 64 * vblk) * 64 + tid * 8;
    const float* elsrc = (const float*)(ws + WS_EL) + (size_t)pu0 * 256 + 64 * kblk + 4 * (tid & 15) + (tid >> 4) * 256;
    const int wofs = (tid >> 3) * 144 + (tid & 7) * 16;
    const int kt = wave >> 1, key0 = 64 * kblk + 16 * kt, v0 = 64 * vblk + 32 * (wave & 1);
    const int kdo = (16 * kt + fr) * 144 + q4 * 16, vfo = 9216 + (32 * (wave & 1) + fr) * 144 + q4 * 16, elo = 147456 + (16 * kt + 4 * q4) * 4;
    v4u rk[8], rv[8]; f32x4 re = {0.f, 0.f, 0.f, 0.f};
#define SC_ISSUE(bt) do { _Pragma("unroll") for (int s = 0; s < 8; ++s) { rk[s] = *(const v4u*)(kdsrc + (size_t)((bt) * 8 + s) * 16384); rv[s] = *(const v4u*)(vtsrc + (size_t)((bt) * 8 + s) * 32768); } \
        if (tid < 128) re = *(const f32x4*)(elsrc + (bt) * 2048); } while (0)
#define SC_COMMIT() do { _Pragma("unroll") for (int s = 0; s < 8; ++s) { *(LAS v4u*)(lds + s * 18432 + wofs) = rk[s]; *(LAS v4u*)(lds + s * 18432 + 9216 + wofs) = rv[s]; } \
        if (tid < 128) *(LAS f32x4*)(lds + 147456 + tid * 16) = re; } while (0)
    f32x4 T0 = {0.f, 0.f, 0.f, 0.f}, T1 = {0.f, 0.f, 0.f, 0.f};
    SC_ISSUE(0); SC_COMMIT();
    __syncthreads();
    for (int bt = 0; bt < 8; ++bt) {
        if (bt + 1 < 8) SC_ISSUE(bt + 1);
#pragma unroll
        for (int s = 0; s < 8; ++s) {
            bf16* st = st_ptr(ws, pu0 + bt * 8 + s) + ((size_t)(key0 >> 4) * 512 + v0 + fr) * 16 + 4 * q4;
            { v2u w; w.x = cvtpk(T0[0], T0[1]); w.y = cvtpk(T0[2], T0[3]); *(v2u*)st = w; w.x = cvtpk(T1[0], T1[1]); w.y = cvtpk(T1[2], T1[3]); *(v2u*)(st + 16 * 16) = w; }
            const f32x4 el = *(const LAS f32x4*)(lds + elo + s * 256);
            T0 = T0 * el; T1 = T1 * el;
#pragma unroll
            for (int kb = 0; kb < 2; ++kb) { const bf16x8 kd = *(const LAS bf16x8*)(lds + s * 18432 + kdo + kb * 64);
                const bf16x8 v0f = *(const LAS bf16x8*)(lds + s * 18432 + vfo + kb * 64), v1f = *(const LAS bf16x8*)(lds + s * 18432 + vfo + 16 * 144 + kb * 64);
                T0 = __builtin_amdgcn_mfma_f32_16x16x32_bf16(kd, v0f, T0, 0, 0, 0); T1 = __builtin_amdgcn_mfma_f32_16x16x32_bf16(kd, v1f, T1, 0, 0, 0); }
        }
        __syncthreads();
        if (bt + 1 < 8) SC_COMMIT();
        __syncthreads();
    }
#undef SC_ISSUE
#undef SC_COMMIT
}
__device__ __forceinline__ void gla_out_unit(const Params& P, LAS unsigned char* lds, int u) {
    const int tid = opaque_tid(), lane = tid & 63, wave = tid >> 6, fr = lane & 15, q4 = lane >> 4;
    const int ch = u & 63, h = (u >> 6) & 3, b = u >> 8, tok0 = b * SEQ + ch * 64;
    unsigned char* ws = P.ws;
    const bf16* PROJ = (const bf16*)(ws + WS_PROJ); const bf16* QT = (const bf16*)(ws + WS_QT); const bf16* AM = (const bf16*)(ws + WS_AM); const bf16* VT = (const bf16*)(ws + WS_VT);
    bf16* OB = (bf16*)(ws + WS_OB); const bf16* ST = st_ptr(ws, u);
    LAS bf16* QS = (LAS bf16*)lds;
    LAS bf16* AS = (LAS bf16*)(lds + 33792);
    LAS float* SS = (LAS float*)(lds + 33792 + 9216);
    LAS float* RS = (LAS float*)(lds + 33792 + 9216 + 2048);
#pragma unroll
    for (int it = 0; it < 4; ++it) { const int idx = it * NTHREADS + tid, t = idx >> 5, cc = idx & 31; *(LAS v4u*)(QS + t * 264 + 8 * cc) = *(const v4u*)(QT + ((size_t)u * 64 + t) * 256 + 8 * cc); }
    { const int t = tid >> 3, cc = tid & 7; *(LAS v4u*)(AS + t * 72 + 8 * cc) = *(const v4u*)(AM + ((size_t)u * 64 + t) * 64 + 8 * cc); }
    LAS bf16* RT = (LAS bf16*)(lds + 49152);
#pragma unroll
    for (int it = 0; it < 8; ++it) { const int idx = it * NTHREADS + tid, t = idx >> 6, cc = idx & 63; const v4u rv = *(const v4u*)(PROJ + (size_t)(tok0 + t) * LD0 + 4096 + 512 * h + 8 * cc);
        LAS v2u* d = (LAS v2u*)(RT + t * 516 + 8 * cc); d[0] = (v2u){rv.x, rv.y}; d[1] = (v2u){rv.z, rv.w}; }
    __syncthreads();
    f32x4 acc[4][4];
#pragma unroll
    for (int m = 0; m < 4; ++m)
#pragma unroll
        for (int j = 0; j < 4; ++j) acc[m][j] = (f32x4){0.f, 0.f, 0.f, 0.f};
    const bf16* stp = ST + ((size_t)(q4 >> 1) * 512 + 64 * wave + fr) * 16 + 8 * (q4 & 1); const bf16* vtp = VT + ((size_t)u * 512 + 64 * wave + fr) * 64 + 8 * q4;
#pragma unroll
    for (int kb = 0; kb < 10; ++kb) { bf16x8 bfr[4], afr[4];
#pragma unroll
        for (int j = 0; j < 4; ++j) bfr[j] = kb < 8 ? __builtin_nontemporal_load((const bf16x8*)(stp + (size_t)(2 * kb) * 8192 + 16 * j * 16)) : *(const bf16x8*)(vtp + (size_t)(16 * j) * 64 + 32 * (kb - 8));
#pragma unroll
        for (int m = 0; m < 4; ++m) afr[m] = kb < 8 ? *(const LAS bf16x8*)(QS + (16 * m + fr) * 264 + 32 * kb + 8 * q4) : *(const LAS bf16x8*)(AS + (16 * m + fr) * 72 + 32 * (kb - 8) + 8 * q4);
#pragma unroll
        for (int m = 0; m < 4; ++m)
#pragma unroll
            for (int j = 0; j < 4; ++j) acc[m][j] = __builtin_amdgcn_mfma_f32_16x16x32_bf16(afr[m], bfr[j], acc[m][j], 0, 0, 0); }
#pragma unroll
    for (int m = 0; m < 4; ++m)
#pragma unroll
        for (int i = 0; i < 4; ++i) { float s = 0.f;
#pragma unroll
            for (int j = 0; j < 4; ++j) s += acc[m][j][i] * acc[m][j][i];
            s += __shfl_xor(s, 1); s += __shfl_xor(s, 2); s += __shfl_xor(s, 4); s += __shfl_xor(s, 8);
            if (fr == 0) SS[wave * 64 + 16 * m + 4 * q4 + i] = s; }
    __syncthreads();
    if (tid < 64) { float s = 0.f;
#pragma unroll
        for (int w = 0; w < 8; ++w) s += SS[w * 64 + tid];
        RS[tid] = 1.0f / sqrtf(s * (1.0f / 512.0f) + 1e-6f); }
    __syncthreads();
    const float* ogn = (const float*)(ws + WS_OGAIN); float gn[4];
#pragma unroll
    for (int j = 0; j < 4; ++j) gn[j] = ogn[64 * wave + 16 * j + fr];
#pragma unroll
    for (int m = 0; m < 4; ++m) { const f32x4 rs4 = *(const LAS f32x4*)(RS + 16 * m + 4 * q4);
#pragma unroll
        for (int i = 0; i < 4; ++i) { const int t = 16 * m + 4 * q4 + i; LAS bf16* rp = RT + t * 516 + 64 * wave + fr;
#pragma unroll
            for (int j = 0; j < 4; ++j) { const float r = bf2f(rp[16 * j]); rp[16 * j] = (bf16)f2bf(acc[m][j][i] * rs4[i] * gn[j] * (r * __builtin_amdgcn_rcpf(1.0f + __expf(-r)))); } }
        SBAR(); }
    __syncthreads();
#pragma unroll
    for (int it = 0; it < 16; ++it) { const int idx = it * NTHREADS + tid, t = idx >> 7, cc = idx & 127; *(v2u*)(OB + (size_t)(tok0 + t) * DM + 512 * h + 4 * cc) = *(const LAS v2u*)(RT + t * 516 + 4 * cc); }
    __syncthreads();
}
constexpr float LOG2E = 1.4426950408889634f;
__device__ __forceinline__ void fox_prep(const Params& P, LAS unsigned char* lds) {
    const int tid = opaque_tid(), lane = tid & 63, wave = tid >> 6;
    unsigned char* ws = P.ws;
    const float* qgn = (const float*)(ws + WS_QGAIN); const float* kgn = (const float*)(ws + WS_KGAIN);
    const float qs = 0.08838834764831845f * LOG2E;
    if (blockIdx.x == 0 && wave == 0) { float mq = 0.f, mk = 0.f;
        for (int i = lane; i < 128; i += 64) { mq = fmaxf(mq, fabsf(qgn[i])); mk = fmaxf(mk, fabsf(kgn[i])); }
#pragma unroll
        for (int o = 1; o < 64; o <<= 1) { mq = fmaxf(mq, __shfl_xor(mq, o)); mk = fmaxf(mk, __shfl_xor(mk, o)); }
        if (lane == 0) *(float*)(ws + WS_THR) = 2.0f * (128.0f * mq * mk * qs * 1.05f) + 130.0f; }
    const float* FLR = (const float*)(ws + WS_GLR); float* CF = (float*)(ws + WS_CF);
    for (int sq = blockIdx.x; sq < 32; sq += gridDim.x) { const int b = sq >> 4, h = sq & 15; const float bf = ((const float*)(ws + WS_BF))[h];
        float v[8]; float cum = 0.f;
#pragma unroll
        for (int i = 0; i < 8; ++i) v[i] = FLR[(size_t)(b * SEQ + tid * 8 + i) * 16 + h];
#pragma unroll
        for (int i = 0; i < 8; ++i) { const float z = v[i] + bf; cum += fminf(z, 0.f) - log1pf(expf(-fabsf(z))); v[i] = cum; }
        float incl = cum;
#pragma unroll
        for (int o = 1; o < 64; o <<= 1) { const float t = __shfl_up(incl, o); if (lane >= o) incl += t; }
        LAS float* wt = (LAS float*)lds;
        if (lane == 63) wt[wave] = incl;
        __syncthreads();
        float woff = 0.f;
#pragma unroll
        for (int w = 0; w < 8; ++w) woff += (w < wave) ? wt[w] : 0.f;
        const float excl = woff + incl - cum;
        f32x4 o0, o1;
#pragma unroll
        for (int i = 0; i < 4; ++i) { o0[i] = (v[i] + excl) * LOG2E; o1[i] = (v[4 + i] + excl) * LOG2E; }
        f32x4* dst = (f32x4*)(CF + (size_t)sq * SEQ + tid * 8); dst[0] = o0; dst[1] = o1;
        __syncthreads();
    }
}
#define KSWZ(row, colB) ((row) * 256 + ((colB) ^ (((row) & 7) << 4)))
constexpr int SHM_K = 16384, SHM_V = 16384;
__device__ __forceinline__ int v_st(int k, int c) { const int kk = (k & ~0xC) | ((k & 4) << 1) | ((k & 8) >> 1); return ((kk >> 3) * 4 + (c >> 5)) * 512 + ((kk & 7) * 32 + (c & 31)) * 2; }
__device__ __forceinline__ int v_rd_base(int lane) { return ((lane & 3) << 3) | (((lane >> 2) & 3) << 6) | (((lane >> 4) & 1) << 5) | (((lane >> 5) & 1) << 8); }
constexpr int v_rd_off(int d0, int ks, int half) { return d0 * 512 + ks * 4096 + half * 2048; }
__device__ __forceinline__ int crow(int r, int hi) { return (r & 3) + 8 * (r >> 2) + 4 * hi; }
template <int KB>
__device__ __forceinline__ void qkt(f32x16& p0, f32x16& p1, const char* K_lds, int r32, int hi, const bf16x8* qs) {
    p0 = f32x16{}; p1 = f32x16{};
    const char* kb[4];
#pragma unroll
    for (int dd = 0; dd < 4; ++dd) kb[dd] = K_lds + KB * SHM_K + KSWZ(r32, (dd * 16 + hi * 8) * 2);
#pragma unroll
    for (int d0 = 0; d0 < 8; ++d0) { const char* a = kb[d0 & 3] + (d0 >> 2) * 128;
        bf16x8 b0 = *reinterpret_cast<const bf16x8*>(a);
        bf16x8 b1 = *reinterpret_cast<const bf16x8*>(a + 32 * 256);
        const bf16x8 qf = qs[d0 * 64];
        p0 = __builtin_amdgcn_mfma_f32_32x32x16_bf16(b0, qf, p0, 0, 0, 0);
        p1 = __builtin_amdgcn_mfma_f32_32x32x16_bf16(b1, qf, p1, 0, 0, 0); }
}
template <int VB>
__device__ __forceinline__ void pv_tile(f32x16* o, int vb0, bf16x8 pa0, bf16x8 pa1, bf16x8 pa2, bf16x8 pa3) {
#define TRRD(dst, off) asm volatile("ds_read_b64_tr_b16 %0, %1 offset:%2" : "=&v"(dst) : "v"(vb0), "i"(off) : "memory")
#define PV_RD(S, d0) do { constexpr int b_ = VB * SHM_V + v_rd_off(d0, 0, 0); \
        TRRD(S##l0, b_); TRRD(S##h0, b_ + 2048); TRRD(S##l1, b_ + 4096); TRRD(S##h1, b_ + 6144); TRRD(S##l2, b_ + 8192); TRRD(S##h2, b_ + 10240); TRRD(S##l3, b_ + 12288); TRRD(S##h3, b_ + 14336); } while (0)
#define PV_WAIT(n) do { asm volatile("s_waitcnt lgkmcnt(%0)" :: "i"(n) : "memory"); SBAR(); } while (0)
#define PV_MM(S, d0) do { \
        o[d0] = __builtin_amdgcn_mfma_f32_32x32x16_bf16(pa0, (bf16x8){S##l0[0], S##l0[1], S##l0[2], S##l0[3], S##h0[0], S##h0[1], S##h0[2], S##h0[3]}, o[d0], 0, 0, 0); \
        o[d0] = __builtin_amdgcn_mfma_f32_32x32x16_bf16(pa1, (bf16x8){S##l1[0], S##l1[1], S##l1[2], S##l1[3], S##h1[0], S##h1[1], S##h1[2], S##h1[3]}, o[d0], 0, 0, 0); \
        o[d0] = __builtin_amdgcn_mfma_f32_32x32x16_bf16(pa2, (bf16x8){S##l2[0], S##l2[1], S##l2[2], S##l2[3], S##h2[0], S##h2[1], S##h2[2], S##h2[3]}, o[d0], 0, 0, 0); \
        o[d0] = __builtin_amdgcn_mfma_f32_32x32x16_bf16(pa3, (bf16x8){S##l3[0], S##l3[1], S##l3[2], S##l3[3], S##h3[0], S##h3[1], S##h3[2], S##h3[3]}, o[d0], 0, 0, 0); } while (0)
    s16x4 Al0, Al1, Al2, Al3, Ah0, Ah1, Ah2, Ah3, Bl0, Bl1, Bl2, Bl3, Bh0, Bh1, Bh2, Bh3;
    PV_RD(A, 0); PV_RD(B, 1); PV_WAIT(8); PV_MM(A, 0);
    PV_RD(A, 2); PV_WAIT(8); PV_MM(B, 1);
    PV_RD(B, 3); PV_WAIT(8); PV_MM(A, 2);
    PV_WAIT(0); PV_MM(B, 3);
#undef PV_RD
#undef PV_WAIT
#undef PV_MM
#undef TRRD
}
__device__ __forceinline__ bf16x8 knorm8(bf16x8 x, const float* g) {
    const v4u xv = __builtin_bit_cast(v4u, x); float f[8];
#pragma unroll
    for (int e = 0; e < 4; ++e) { f[2 * e] = __builtin_bit_cast(float, xv[e] << 16); f[2 * e + 1] = __builtin_bit_cast(float, xv[e] & 0xffff0000u); }
    float s = 0.f;
#pragma unroll
    for (int e = 0; e < 8; ++e) s += f[e] * f[e];
    s += __shfl_xor(s, 1); s += __shfl_xor(s, 2); s += __shfl_xor(s, 4); s += __shfl_xor(s, 8);
    const float r = __builtin_amdgcn_rsqf(s * (1.0f / 128.0f) + 1e-6f);
    const f32x4 g0 = *(const f32x4*)g, g1 = *(const f32x4*)(g + 4);
    v4u w; w.x = cvtpk(f[0] * r * g0[0], f[1] * r * g0[1]); w.y = cvtpk(f[2] * r * g0[2], f[3] * r * g0[3]); w.z = cvtpk(f[4] * r * g1[0], f[5] * r * g1[1]); w.w = cvtpk(f[6] * r * g1[2], f[7] * r * g1[3]);
    return __builtin_bit_cast(bf16x8, w);
}
template <int BUF>
__device__ __forceinline__ void fox_tile(f32x16* o, float& m_reg, float& l_reg, const char* lds, const float* ckl, float* al_l, int vb0, const bf16x8* qr, float cq, int qpos, int kb0, bool need_mask, int r32, int hi) {
    f32x16 p0, p1;
    qkt<BUF>(p0, p1, lds + 2 * SHM_V, r32, hi, qr);
    const float* ck = ckl + kb0 + 4 * hi;
#pragma unroll
    for (int g = 0; g < 4; ++g) { const f32x4 c0 = *(const f32x4*)(ck + 8 * g), c1 = *(const f32x4*)(ck + 32 + 8 * g);
#pragma unroll
        for (int e = 0; e < 4; ++e) { p0[4 * g + e] += cq - c0[e]; p1[4 * g + e] += cq - c1[e]; } }
    if (need_mask) { const float NEG = -__builtin_inff(); const int dq = qpos - kb0 - 4 * hi;
#pragma unroll
        for (int r = 0; r < 16; ++r) { const int c = (r & 3) + 8 * (r >> 2); if (c > dq) p0[r] = NEG; if (c + 32 > dq) p1[r] = NEG; } }
    float pmax = p0[0];
#pragma unroll
    for (int r = 1; r < 16; ++r) pmax = fmaxf(pmax, p0[r]);
#pragma unroll
    for (int r = 0; r < 16; ++r) pmax = fmaxf(pmax, p1[r]);
    { auto rr = __builtin_amdgcn_permlane32_swap(__float_as_uint(pmax), __float_as_uint(pmax), false, false); pmax = fmaxf(__uint_as_float(rr[0]), __uint_as_float(rr[1])); }
    const float mn = fmaxf(m_reg, pmax), alpha = __builtin_amdgcn_exp2f(m_reg - mn); m_reg = mn;
    float ps = 0.f;
#pragma unroll
    for (int r = 0; r < 16; ++r) { p0[r] = __builtin_amdgcn_exp2f(p0[r] - mn); p1[r] = __builtin_amdgcn_exp2f(p1[r] - mn); ps += p0[r] + p1[r]; }
    { auto rr = __builtin_amdgcn_permlane32_swap(__float_as_uint(ps), __float_as_uint(ps), false, false); ps = __uint_as_float(rr[0]) + __uint_as_float(rr[1]); }
    l_reg = l_reg * alpha + ps;
    bf16x8 pa0, pa1, pa2, pa3;
#define PK4(Pv, B_, OUT) do { unsigned a0 = cvtpk(Pv[B_+0], Pv[B_+1]), a1 = cvtpk(Pv[B_+2], Pv[B_+3]); unsigned b0 = cvtpk(Pv[B_+4], Pv[B_+5]), b1 = cvtpk(Pv[B_+6], Pv[B_+7]); \
        auto r0 = __builtin_amdgcn_permlane32_swap(a0, b0, false, false); auto r1 = __builtin_amdgcn_permlane32_swap(a1, b1, false, false); \
        v4u w = {r0[0], r1[0], r0[1], r1[1]}; OUT = __builtin_bit_cast(bf16x8, w); } while (0)
    PK4(p0, 0, pa0); PK4(p0, 8, pa1); PK4(p1, 0, pa2); PK4(p1, 8, pa3);
#undef PK4
    if (__any(alpha < 1.f)) { if (hi == 0) al_l[r32] = alpha; asm volatile("s_waitcnt lgkmcnt(0)" ::: "memory");
#pragma unroll
        for (int d_ = 0; d_ < 4; ++d_)
#pragma unroll
            for (int r = 0; r < 16; ++r) o[d_][r] *= al_l[crow(r, hi)]; }
    SBAR();
    pv_tile<BUF>(o, vb0, pa0, pa1, pa2, pa3);
}
__device__ __forceinline__ void fox_attn_unit(const Params& P, char* lds, int b, int h, int qb) {
    const int tid = opaque_tid(), wid = __builtin_amdgcn_readfirstlane(tid >> 6), lane = tid & 63, r32 = lane & 31, hi = lane >> 5;
    unsigned char* ws = P.ws; const bf16* PROJ = (const bf16*)(ws + WS_PROJ); const float* CF = (const float*)(ws + WS_CF) + (size_t)(b * 16 + h) * SEQ; bf16* OB = (bf16*)(ws + WS_OB);
    char* V_lds = lds; char* K_lds = lds + 2 * SHM_V;
    float* ckl = (float*)(lds + 2 * SHM_V + 2 * SHM_K);
    float* al_l = (float*)(lds + 2 * SHM_V + 2 * SHM_K + 16384) + wid * 64;
    const int q0 = qb * 256, qlo = q0 + wid * 32, qpos = qlo + r32;
    const bf16* Qp = PROJ + (size_t)(b * SEQ + qpos) * LD1 + h * 128 + hi * 8;
    const bf16* Kh = PROJ + (size_t)(b * SEQ) * LD1 + 2048 + h * 128; const bf16* Vh = Kh + 2048;
    bf16x8* qr = (bf16x8*)(lds + 83968 + wid * 8192) + lane;
    float* kgl = (float*)(lds + 149504);
    if (tid < 32) ((f32x4*)kgl)[tid] = ((const f32x4*)(ws + WS_KGAIN))[tid];
    {
      v4u qv[8]; float ssq = 0.f;
#pragma unroll
      for (int d0 = 0; d0 < 8; ++d0) { qv[d0] = *(const v4u*)(Qp + d0 * 16);
#pragma unroll
          for (int e = 0; e < 4; ++e) { const float a = __builtin_bit_cast(float, qv[d0][e] << 16), c = __builtin_bit_cast(float, qv[d0][e] & 0xffff0000u); ssq += a * a + c * c; } }
      ssq += __shfl_xor(ssq, 32);
      const float rq = (0.08838834764831845f * LOG2E) / sqrtf(ssq * (1.0f / 128.0f) + 1e-6f); const float* qgn = (const float*)(ws + WS_QGAIN) + hi * 8;
#pragma unroll
      for (int d0 = 0; d0 < 8; ++d0) { const f32x4 g0 = *(const f32x4*)(qgn + d0 * 16), g1 = *(const f32x4*)(qgn + d0 * 16 + 4); v4u w;
#pragma unroll
          for (int e = 0; e < 4; ++e) { const float a = __builtin_bit_cast(float, qv[d0][e] << 16), c = __builtin_bit_cast(float, qv[d0][e] & 0xffff0000u); const float ga = e < 2 ? g0[2 * e] : g1[2 * e - 4], gc = e < 2 ? g0[2 * e + 1] : g1[2 * e - 3];
              w[e] = cvtpk(a * rq * ga, c * rq * gc); }
          qr[d0 * 64] = __builtin_bit_cast(bf16x8, w); } }
    const float cq = CF[qpos];
    const int sr = tid >> 4, sc = (tid & 15) * 8, vst0 = v_st(sr, sc), vst1 = v_st(32 + sr, sc), kws = KSWZ(sr, sc * 2);
    const int vb0 = (int)(uintptr_t)V_lds + v_rd_base(lane);
    const int NT = 4 * (qb + 1);
    bf16x8 st_k0, st_k1, st_v0, st_v1;
    for (int i = tid; i < (q0 + 256) / 4; i += NTHREADS) ((f32x4*)ckl)[i] = ((const f32x4*)CF)[i];
#define SLOAD(t) do { const size_t r0_ = (size_t)((t) * 64 + sr) * LD1 + sc; st_k0 = *(const bf16x8*)(Kh + r0_); st_k1 = *(const bf16x8*)(Kh + r0_ + (size_t)32 * LD1); \
        st_v0 = *(const bf16x8*)(Vh + r0_); st_v1 = *(const bf16x8*)(Vh + r0_ + (size_t)32 * LD1); } while (0)
#define SWRITE(bf) do { *(bf16x8*)(K_lds + (bf) * SHM_K + kws) = knorm8(st_k0, kgl + sc); *(bf16x8*)(K_lds + (bf) * SHM_K + kws + 32 * 256) = knorm8(st_k1, kgl + sc); \
        *(bf16x8*)(V_lds + (bf) * SHM_V + vst0) = st_v0; *(bf16x8*)(V_lds + (bf) * SHM_V + vst1) = st_v1; } while (0)
    float m_reg = -1e30f, l_reg = 0.f; f32x16 o[4] = {};
    __syncthreads();
    int j_lo; { const float thr = *(const float*)(ws + WS_THR), cq0 = ckl[q0];
        const bool skip = lane < 4 * qb && ckl[64 * lane + 63] - cq0 > thr; const unsigned long long bm = __ballot(!skip); j_lo = (int)__builtin_ctzll(bm) & ~1; }
    SLOAD(NT - 1); SWRITE(0);
    __syncthreads();
    for (int t = NT - 1; t > j_lo; t -= 2) {
        SLOAD(t - 1);
        { const int kb0 = t * 64; fox_tile<0>(o, m_reg, l_reg, lds, ckl, al_l, vb0, qr, cq, qpos, kb0, kb0 + 63 > qlo, r32, hi); }
        SWRITE(1);
        __syncthreads();
        if (t - 2 > j_lo) SLOAD(t - 2);
        { const int kb0 = (t - 1) * 64; fox_tile<1>(o, m_reg, l_reg, lds, ckl, al_l, vb0, qr, cq, qpos, kb0, kb0 + 63 > qlo, r32, hi); }
        if (t - 2 > j_lo) SWRITE(0);
        __syncthreads();
    }
#undef SLOAD
#undef SWRITE
    if (hi == 0) al_l[r32] = l_reg; asm volatile("s_waitcnt lgkmcnt(0)" ::: "memory");
    bf16* stg = (bf16*)(lds + wid * 8192);
#pragma unroll
    for (int r = 0; r < 16; ++r) { const int row = crow(r, hi); const float rl = __builtin_amdgcn_rcpf(al_l[row]);
#pragma unroll
        for (int d_ = 0; d_ < 4; ++d_) stg[row * 128 + d_ * 32 + r32] = (bf16)f2bf(o[d_][r] * rl); }
    asm volatile("s_waitcnt lgkmcnt(0)" ::: "memory");
    { const int ch = lane & 15; const bf16* ogp = PROJ + (size_t)(b * SEQ + qlo) * LD1 + 6144 + h * 128 + ch * 8; bf16* op = OB + (size_t)(b * SEQ + qlo) * DM + h * 128 + ch * 8;
#pragma unroll 2
      for (int i = 0; i < 8; ++i) { const int row = i * 4 + (lane >> 4); const v4u ov = *(const v4u*)(stg + row * 128 + ch * 8); const v4u gv = *(const v4u*)(ogp + (size_t)row * LD1); v4u w;
#pragma unroll
          for (int e = 0; e < 4; ++e) { const float o0 = __builtin_bit_cast(float, ov[e] << 16), o1 = __builtin_bit_cast(float, ov[e] & 0xffff0000u), g0 = __builtin_bit_cast(float, gv[e] << 16), g1 = __builtin_bit_cast(float, gv[e] & 0xffff0000u);
              w[e] = pk2(o0 * __builtin_amdgcn_rcpf(1.0f + __expf(-g0)), o1 * __builtin_amdgcn_rcpf(1.0f + __expf(-g1))); }
          *(v4u*)(op + (size_t)row * DM) = w; } }
    __syncthreads();
}
#define RLX_AGENT __ATOMIC_RELAXED, __HIP_MEMORY_SCOPE_AGENT
#define XB_TMO      128
#define XB_XCNT(j)  (256  + 64 * (j))
#define XB_XSUB(j)  (1280 + 64 * (j))
#define XB_XGEN(j)  (2304 + 64 * (j))
#define XB_TOP      3328
#define XB_TOPGEN   3392
#define XCD_BAR_WORDS 3456
#define XB_SPIN_CAP (1u << 18)

__device__ __forceinline__ unsigned xb_ld(unsigned* p)              { return __hip_atomic_load(p, __ATOMIC_RELAXED, __HIP_MEMORY_SCOPE_AGENT); }
__device__ __forceinline__ unsigned xb_add(unsigned* p, unsigned v) { return __hip_atomic_fetch_add(p, v, __ATOMIC_RELAXED, __HIP_MEMORY_SCOPE_AGENT); }
__device__ __forceinline__ unsigned xb_xcc_id() { return (unsigned)__builtin_amdgcn_s_getreg((3 << 11) | 20) & 0xFu; }
#define XB_SPIN(cond, bar) do { unsigned _sp = 0; while (cond) { __builtin_amdgcn_s_sleep(1); \
    if ((++_sp & 255u) == 0u) { if (xb_ld(&(bar)[XB_TMO])) break; if (_sp > XB_SPIN_CAP) { atomicAdd(&(bar)[XB_TMO], 1u); break; } } } } while (0)

struct XcdBarrier {
    unsigned* bar; unsigned x;
    volatile LAS unsigned* st;
};

__device__ __forceinline__ XcdBarrier xcd_barrier_post(unsigned* bar, volatile LAS unsigned* st) {
    XcdBarrier b; b.bar = bar; b.x = xb_xcc_id(); b.st = st;
    if (threadIdx.x == 0) (void)xb_add(&bar[XB_XCNT(b.x)], 1u);
    return b;
}
__device__ __forceinline__ void xcd_barrier_complete(unsigned* bar, unsigned x, unsigned& nloc, unsigned& nx) {
    const unsigned G = gridDim.x * gridDim.y * gridDim.z;
    unsigned sum, cnt, mine, sp = 0u;
    for (;;) {
        sum = 0u; cnt = 0u; mine = 0u;
#pragma unroll
        for (unsigned j = 0; j < 16; ++j) { const unsigned c = xb_ld(&bar[XB_XCNT(j)]); sum += c; cnt += (c > 0u) ? 1u : 0u; mine = (j == x) ? c : mine; }
        if (sum == G) break;
        __builtin_amdgcn_s_sleep(1);
        if ((++sp & 255u) == 0u) { if (xb_ld(&bar[XB_TMO])) break; if (sp > XB_SPIN_CAP) { atomicAdd(&bar[XB_TMO], 1u); break; } }
    }
    nloc = mine > 0u ? mine : 1u; nx = cnt > 0u ? cnt : 1u;
}

__device__ __forceinline__ void xcd_barrier(const XcdBarrier& b) {
    asm volatile("s_waitcnt vmcnt(0)" ::: "memory");
    __syncthreads();
    if (threadIdx.x == 0) {
        unsigned* bar = b.bar;
        __builtin_amdgcn_s_waitcnt(0);
        unsigned nloc = b.st[0], nx = b.st[1];
        if (nloc == 0u) { xcd_barrier_complete(bar, b.x, nloc, nx); b.st[0] = nloc; b.st[1] = nx; }
        const unsigned old = xb_add(&bar[XB_XSUB(b.x)], 1u);
        const unsigned gen = old / nloc;
        if (old + 1u == (gen + 1u) * nloc) {
            __builtin_amdgcn_fence(__ATOMIC_RELEASE, "agent");
            asm volatile("s_waitcnt vmcnt(0)" ::: "memory");
            const unsigned og = xb_add(&bar[XB_TOP], 1u);
            const unsigned tg = og / nx;
            if (og + 1u != (tg + 1u) * nx) XB_SPIN(xb_ld(&bar[XB_TOP]) < (tg + 1u) * nx, bar);
            __builtin_amdgcn_fence(__ATOMIC_ACQUIRE, "agent");
            xb_add(&bar[XB_XGEN(b.x)], 1u);
            asm volatile("s_waitcnt vmcnt(0)" ::: "memory");
        } else {
            XB_SPIN(xb_ld(&bar[XB_XGEN(b.x)]) == gen, bar);
            __builtin_amdgcn_fence(__ATOMIC_ACQUIRE, "agent");
            asm volatile("s_waitcnt vmcnt(0)" ::: "memory");
        }
    }
    __syncthreads();
}
constexpr int N_PHASES = 14;
#ifndef MK_MULTI
#define MK_MULTI 0
#endif
__global__ void __launch_bounds__(NTHREADS, 2) hybrid_fwd(Params P) {
    extern __shared__ __attribute__((aligned(16))) unsigned char lds_raw[];
    LAS unsigned char* lds = (LAS unsigned char*)lds_raw;
    cg::grid_group grid = cg::this_grid();
    unsigned char* ws = P.ws;
    volatile LAS unsigned* bst = (volatile LAS unsigned*)(lds + LDS_BYTES - 64);
    if (threadIdx.x == 0) { bst[0] = 0u; bst[1] = 0u; }
    __syncthreads();
    XcdBarrier xbar = xcd_barrier_post((unsigned*)(ws + WS_BAR), bst);
    const int vcu = (gridDim.x % 8 == 0) ? (int)((blockIdx.x % 8) * (gridDim.x / 8) + blockIdx.x / 8) : (int)blockIdx.x;
#if MK_MULTI
    const int lo = P.ph_lo, hi = P.ph_hi;
#else
    constexpr int lo = 0, hi = 14;
#endif
    bf16* XB = (bf16*)(ws + WS_XB); bf16* OB = (bf16*)(ws + WS_OB); bf16* PROJ = (bf16*)(ws + WS_PROJ); float* SSQ = (float*)(ws + WS_SSQ); float* GLR = (float*)(ws + WS_GLR);
#ifndef PHM
#define PHM 0x3fff
#endif
#define IN(k) ((((PHM) >> (k)) & 1) && lo <= (k) && (k) < hi)
#ifndef DUP
#define DUP -1
#endif
#define SEAM(k) do { if (IN(k) && IN((k) + 1)) xcd_barrier(xbar); } while (0)
    if (P.ph_hi < 0) grid.sync();
    for (int rep_ = 0; rep_ < (DUP == 0 ? 2 : 1); ++rep_)
    if (IN(0)) { p0_prologue(P, lds, 0, blockIdx.x, gridDim.x); } SEAM(0);
    if (IN(1)) {
        pg8::Gemm g{XB, (const bf16*)(ws + WS_WGI), M, 6144, DM}; pg8::StaticOrder S; S.init(M, 6144, gridDim.x, blockIdx.x);
        PG8_LAS float* rst = (PG8_LAS float*)(lds + 131072); pg8::fill_rstd_table(rst, SSQ, S);
        pg8::EpiScaleBf16 E{PROJ, LD0, rst};
        pg8::gemm_phase<pg8::EpiScaleBf16, pg8::StaticOrder, true, true>(lds, g, S, E);
        thin_gemm(XB, (const bf16*)(ws + WS_W1T), SSQ, GLR, lds);
    } SEAM(1);
    for (int rep_ = 0; rep_ < (DUP == 2 ? 2 : 1); ++rep_)
    if (IN(2)) { for (int u = blockIdx.x; u < 512; u += gridDim.x) gla_prep_unit(P, lds, u); } SEAM(2);
    for (int rep_ = 0; rep_ < (DUP == 3 ? 2 : 1); ++rep_)
    if (IN(3)) { for (int u = blockIdx.x; u < 256; u += gridDim.x) gla_scan_unit(P, lds, u); } SEAM(3);
    for (int rep_ = 0; rep_ < (DUP == 4 ? 2 : 1); ++rep_)
    if (IN(4)) { for (int u = blockIdx.x; u < 512; u += gridDim.x) gla_out_unit(P, lds, u); } SEAM(4);
#ifdef SYNCX
    for (int rep_ = 0; rep_ < SYNCX; ++rep_) xcd_barrier(xbar);
#endif
    for (int rep_ = 0; rep_ < (DUP == 5 ? 2 : 1); ++rep_)
    if (IN(5)) {
        pg8::Gemm g{OB, (const bf16*)(ws + WS_WGO), M, DM, DM}; pg8::StaticOrder S; S.init(M, DM, gridDim.x, blockIdx.x);
        pg8::EpiResid<0> E{P.x, P.out, XB, SSQ};
        pg8::gemm_phase<pg8::EpiResid<0>, pg8::StaticOrder, true, true>(lds, g, S, E);
    } SEAM(5);
    for (int rep_ = 0; rep_ < (DUP == 6 ? 2 : 1); ++rep_)
    if (IN(6)) {
        const int ngemm = (gridDim.x == 256 && DUP != 6) ? 235 : (int)gridDim.x;
        if ((int)blockIdx.x < ngemm) {
        pg8::Gemm g{XB, (const bf16*)(ws + WS_WGU0), M, 2 * DFF, DM}; pg8::StaticOrder S; S.init(M, 2 * DFF, ngemm, blockIdx.x);
        PG8_LAS float* rst = (PG8_LAS float*)(lds + 131072); pg8::fill_rstd_table(rst, SSQ, S);
        pg8::EpiSwiGLU E{PROJ, DFF, rst};
        pg8::gemm_phase<pg8::EpiSwiGLU, pg8::StaticOrder, true, true>(lds, g, S, E);
        if (ngemm == (int)gridDim.x && rep_ == 0) p0_prologue(P, lds, 1, blockIdx.x, gridDim.x);
        } else p0_prologue(P, lds, 1, blockIdx.x - ngemm, gridDim.x - ngemm);
    } SEAM(6);
    if (IN(7)) {
        pg8::Gemm g{PROJ, (const bf16*)(ws + WS_WD0), M, DM, DFF}; pg8::StaticOrder S; S.init(M, DM, gridDim.x, blockIdx.x);
        pg8::EpiResid<1> E{nullptr, P.out, XB, SSQ};
        pg8::gemm_phase<pg8::EpiResid<1>, pg8::StaticOrder, true, true>(lds, g, S, E);
    } SEAM(7);
    if (IN(8)) {
        pg8::Gemm g{XB, (const bf16*)(ws + WS_WFI), M, 8192, DM}; pg8::StaticOrder S; S.init(M, 8192, gridDim.x, blockIdx.x);
        PG8_LAS float* rst = (PG8_LAS float*)(lds + 131072); pg8::fill_rstd_table(rst, SSQ, S);
        pg8::EpiScaleBf16 E{PROJ, LD1, rst};
        pg8::gemm_phase<pg8::EpiScaleBf16, pg8::StaticOrder, true, true>(lds, g, S, E);
        thin_gemm(XB, (const bf16*)(ws + WS_WFT), SSQ, GLR, lds);
    } SEAM(8);
    if (IN(9)) { fox_prep(P, lds); } SEAM(9);
    for (int rep_ = 0; rep_ < (DUP == 10 ? 2 : 1); ++rep_)
    if (IN(10)) {
        for (int pr = vcu; pr < 256; pr += gridDim.x) { const int bh = pr >> 3, s = pr & 7;
            fox_attn_unit(P, (char*)lds_raw, bh >> 4, bh & 15, 15 - s); fox_attn_unit(P, (char*)lds_raw, bh >> 4, bh & 15, s); }
    } SEAM(10);
    if (IN(11)) {
        pg8::Gemm g{OB, (const bf16*)(ws + WS_WFO), M, DM, DM}; pg8::StaticOrder S; S.init(M, DM, gridDim.x, blockIdx.x);
        pg8::EpiResid<1> E{nullptr, P.out, XB, SSQ};
        pg8::gemm_phase<pg8::EpiResid<1>, pg8::StaticOrder, true, true>(lds, g, S, E);
    } SEAM(11);
    if (IN(12)) {
        const int ngemm = gridDim.x == 256 ? 235 : (int)gridDim.x;
        if ((int)blockIdx.x < ngemm) {
        pg8::Gemm g{XB, (const bf16*)(ws + WS_WGU1), M, 2 * DFF, DM}; pg8::StaticOrder S; S.init(M, 2 * DFF, ngemm, blockIdx.x);
        PG8_LAS float* rst = (PG8_LAS float*)(lds + 131072); pg8::fill_rstd_table(rst, SSQ, S);
        pg8::EpiSwiGLU E{PROJ, DFF, rst};
        pg8::gemm_phase<pg8::EpiSwiGLU, pg8::StaticOrder, true, true>(lds, g, S, E);
        if (ngemm == (int)gridDim.x) p0_prologue(P, lds, 2, blockIdx.x, gridDim.x);
        } else p0_prologue(P, lds, 2, blockIdx.x - ngemm, gridDim.x - ngemm);
    } SEAM(12);
    if (IN(13)) {
        pg8::Gemm g{PROJ, (const bf16*)(ws + WS_WD1), M, DM, DFF}; pg8::StaticOrder S; S.init(M, DM, gridDim.x, blockIdx.x);
        pg8::EpiResid<2> E{nullptr, P.out, XB, SSQ};
        pg8::gemm_phase<pg8::EpiResid<2>, pg8::StaticOrder, true, true>(lds, g, S, E);
    }
#undef IN
#undef SEAM
}

extern "C" void kernel_launch(void* const* d_in, const int* in_sizes, int n_in, void* d_out, int out_size, void* d_ws, size_t ws_size, hipStream_t stream) {
    static int grid = 0;
    if (grid == 0) {
        if (n_in != 16 || in_sizes[0] != M * DM || out_size != M * DM || ws_size < WS_END) { fprintf(stderr, "kernel_launch: unexpected shapes/workspace (n_in %d, ws %zu, need %zu)\n", n_in, ws_size, (size_t)WS_END); grid = -1; return; }
        int dev = 0, cus = 0, per_cu = 0;
        hipGetDevice(&dev); hipDeviceGetAttribute(&cus, hipDeviceAttributeMultiprocessorCount, dev);
        if (hipFuncSetAttribute((const void*)hybrid_fwd, hipFuncAttributeMaxDynamicSharedMemorySize, LDS_BYTES) != hipSuccess) { fprintf(stderr, "kernel_launch: hipFuncSetAttribute failed\n"); grid = -1; return; }
        if (hipOccupancyMaxActiveBlocksPerMultiprocessor(&per_cu, (const void*)hybrid_fwd, NTHREADS, LDS_BYTES) != hipSuccess || per_cu < 1) { fprintf(stderr, "kernel_launch: occupancy query gives %d\n", per_cu); per_cu = 1; (void)hipGetLastError(); }
        grid = cus * per_cu;
        fprintf(stderr, "kernel_launch: grid %d (%d CUs x %d)\n", grid, cus, per_cu);
    }
    if (grid < 0) return;
    if (hipMemsetAsync((char*)d_ws + WS_BAR, 0, 16384, stream) != hipSuccess) { fprintf(stderr, "kernel_launch: memset failed\n"); return; }
    Params p{};
    const float* const* in = (const float* const*)d_in;
    p.x = in[0]; p.norm_mix = in[1]; p.norm_ffn = in[2]; p.gla_w_in = in[3]; p.gla_w_g2 = in[4]; p.gla_b_g2 = in[5]; p.gla_o_gain = in[6]; p.gla_w_o = in[7];
    p.fox_w_in = in[8]; p.fox_b_f = in[9]; p.fox_q_gain = in[10]; p.fox_k_gain = in[11]; p.fox_w_o = in[12]; p.ffn_w_gate = in[13]; p.ffn_w_up = in[14]; p.ffn_w_down = in[15];
    p.out = (float*)d_out; p.ws = (unsigned char*)d_ws;
#if MK_MULTI
    for (int ph = 0; ph < N_PHASES; ++ph) { p.ph_lo = ph; p.ph_hi = ph + 1; hipLaunchKernelGGL(hybrid_fwd, dim3(grid), dim3(NTHREADS), LDS_BYTES, stream, p); }
#else
    p.ph_lo = 0; p.ph_hi = N_PHASES;
    void* args[] = {&p};
    hipError_t e = hipLaunchCooperativeKernel((const void*)hybrid_fwd, dim3(grid), dim3(NTHREADS), args, LDS_BYTES, stream);
    if (e != hipSuccess) fprintf(stderr, "cooperative launch failed: %s (grid %d)\n", hipGetErrorString(e), grid);
#endif
}
```
